# Optimizing an MI355X kernel written in HIP

```python
import jax, jax.numpy as jnp
from jax import lax
import numpy as np

D_MODEL = 4096
BATCH = 2
SEQ = 8192
DEPTH = 2

N_MIXERS = 2
N_A = (DEPTH + 1) // 2
N_B = DEPTH // 2

ML_HEADS = 8
ML_V_DIM = D_MODEL // ML_HEADS
ML_QK_DIM = ML_V_DIM // 2
ML_CHUNK = 64
GATE_SOFTCAP = 15.0
ML_IN_COLS = ML_HEADS * (2 * ML_QK_DIM + ML_V_DIM) + D_MODEL + 2 * ML_HEADS

MB_HEADS = 32
MB_HEAD_DIM = D_MODEL // MB_HEADS
MB_BLOCK = 256
MB_TOPK = 3
MB_QUERY_CHUNK = 16

D_FF = -(-(8 * D_MODEL // 3) // 256) * 256
CONV_WIDTH = 3
NORM_EPS = 1e-6

kernel_name = "hybrid_mlstm_moba_convffn"


def rmsnorm(x, g):
    xf = x.astype(jnp.float32)
    y = xf * lax.rsqrt(jnp.mean(xf * xf, axis=-1, keepdims=True) + NORM_EPS)
    return (y * g.astype(jnp.float32)).astype(x.dtype)


def mlstm_mixer(xn, w_in, gate_bias, head_gain, w_out):
    bsz, seq, _ = xn.shape
    H, dk, dv, L = ML_HEADS, ML_QK_DIM, ML_V_DIM, ML_CHUNK
    f32 = jnp.float32
    proj = xn @ w_in
    s1 = H * dk
    s2 = 2 * H * dk
    s3 = s2 + H * dv
    s4 = s3 + D_MODEL
    o = proj[..., s3:s4]

    def heads(t, d):
        return t.reshape(bsz, seq, H, d).transpose(0, 2, 1, 3).astype(f32)

    q = heads(proj[..., :s1], dk)
    k = heads(proj[..., s1:s2], dk) * (dk ** -0.5)
    v = heads(proj[..., s2:s3], dv)
    g = (proj[..., s4:] + gate_bias).astype(f32)
    g = GATE_SOFTCAP * jnp.tanh(g / GATE_SOFTCAP)
    i_pre = g[..., :H].transpose(0, 2, 1)
    log_f = jax.nn.log_sigmoid(g[..., H:]).transpose(0, 2, 1)

    nc = seq // L

    def to_chunks(t):
        t = t.reshape(t.shape[:2] + (nc, L) + t.shape[3:])
        return jnp.moveaxis(t, 2, 0)

    tril = jnp.tril(jnp.ones((L, L), dtype=bool))

    def step(carry, inp):
        C, n, m = carry
        qc, kc, vc, ic, lfc = inp
        b = jnp.cumsum(lfc, axis=-1)
        dmat = b[..., :, None] - b[..., None, :] + ic[..., None, :]
        dmat = jnp.where(tril, dmat, -jnp.inf)
        inter = b + m[..., None]
        m_row = jnp.maximum(jnp.max(dmat, axis=-1), inter)
        a_inter = jnp.exp(inter - m_row)
        s = jnp.einsum('bhjd,bhid->bhji', qc, kc) * jnp.exp(dmat - m_row[..., None])
        num = (a_inter[..., None] * jnp.einsum('bhjd,bhde->bhje', qc, C)
               + jnp.einsum('bhji,bhie->bhje', s, vc))
        den = a_inter * jnp.einsum('bhjd,bhd->bhj', qc, n) + jnp.sum(s, axis=-1)
        h = num / jnp.maximum(jnp.abs(den), jnp.exp(-m_row))[..., None]
        b_last = b[..., -1]
        dec_i = b_last[..., None] - b + ic
        m_new = jnp.maximum(b_last + m, jnp.max(dec_i, axis=-1))
        w_i = jnp.exp(dec_i - m_new[..., None])
        a_old = jnp.exp(b_last + m - m_new)
        kw = kc * w_i[..., None]
        C_new = a_old[..., None, None] * C + jnp.einsum('bhid,bhie->bhde', kw, vc)
        n_new = a_old[..., None] * n + jnp.sum(kw, axis=2)
        return (C_new, n_new, m_new), h

    init = (jnp.zeros((bsz, H, dk, dv), f32), jnp.zeros((bsz, H, dk), f32),
            jnp.zeros((bsz, H), f32))
    _, hs = lax.scan(step, init, (to_chunks(q), to_chunks(k), to_chunks(v),
                                  to_chunks(i_pre), to_chunks(log_f)))
    h = jnp.moveaxis(hs, 0, 2).reshape(bsz, H, seq, dv)
    h = h * lax.rsqrt(jnp.mean(h * h, axis=-1, keepdims=True) + NORM_EPS)
    h = h.transpose(0, 2, 1, 3).reshape(bsz, seq, D_MODEL) * head_gain.astype(f32)
    h = h * jax.nn.sigmoid(o.astype(f32))
    return h.astype(xn.dtype) @ w_out


def moba_mixer(xn, w_qkv, w_out):
    bsz, seq, _ = xn.shape
    H, dh, bs = MB_HEADS, MB_HEAD_DIM, MB_BLOCK
    f32 = jnp.float32
    q, k, v = jnp.split(xn @ w_qkv, 3, axis=-1)

    def heads(t):
        return t.reshape(bsz, seq, H, dh).transpose(0, 2, 1, 3)

    q, k, v = heads(q), heads(k), heads(v)
    n_blk = -(-seq // bs)
    pad = n_blk * bs - seq
    kp = jnp.pad(k, ((0, 0), (0, 0), (0, pad), (0, 0)))
    vp = jnp.pad(v, ((0, 0), (0, 0), (0, pad), (0, 0)))
    kb = kp.reshape(bsz, H, n_blk, bs, dh)
    vb = vp.reshape(bsz, H, n_blk, bs, dh)
    k_mean = jnp.mean(kb.astype(f32), axis=3)
    gate = jnp.einsum('bhsd,bhnd->bhsn', q.astype(f32), k_mean)
    q_blk = jnp.arange(seq) // bs
    fully_past = jnp.arange(n_blk)[None, :] < q_blk[:, None]
    gate = jnp.where(fully_past, gate, -jnp.inf)
    k_sel = min(MB_TOPK, n_blk)
    _, sel_idx = lax.top_k(gate, k_sel)
    sel_valid = jnp.arange(k_sel)[None, :] < q_blk[:, None]

    qc_len = MB_QUERY_CHUNK
    nq = seq // qc_len
    q_ch = jnp.moveaxis(q.reshape(bsz, H, nq, qc_len, dh), 2, 0)
    idx_ch = jnp.moveaxis(sel_idx.reshape(bsz, H, nq, qc_len, k_sel), 2, 0)
    valid_ch = sel_valid.reshape(nq, qc_len, k_sel)
    gather = jax.vmap(jax.vmap(lambda blocks, ix: blocks[ix]))
    scale = dh ** -0.5

    def attend(args):
        ci, qc, ic, vm = args
        t0 = ci * qc_len
        own = t0 // bs
        k_g = gather(kb, ic)
        v_g = gather(vb, ic)
        s_sel = jnp.einsum('bhqd,bhqjpd->bhqjp', qc, k_g).astype(f32) * scale
        s_sel = jnp.where(vm[None, None, :, :, None], s_sel, -jnp.inf)
        s_sel = s_sel.reshape(bsz, H, qc_len, k_sel * bs)
        k_own = lax.dynamic_slice_in_dim(kp, own * bs, bs, axis=2)
        v_own = lax.dynamic_slice_in_dim(vp, own * bs, bs, axis=2)
        s_own = jnp.einsum('bhqd,bhpd->bhqp', qc, k_own).astype(f32) * scale
        causal = (own * bs + jnp.arange(bs))[None, :] <= (t0 + jnp.arange(qc_len))[:, None]
        s_own = jnp.where(causal, s_own, -jnp.inf)
        p = jax.nn.softmax(jnp.concatenate([s_sel, s_own], axis=-1), axis=-1)
        p_sel = p[..., :k_sel * bs].reshape(bsz, H, qc_len, k_sel, bs)
        p_own = p[..., k_sel * bs:]
        out = (jnp.einsum('bhqjp,bhqjpe->bhqe', p_sel, v_g.astype(f32))
               + jnp.einsum('bhqp,bhpe->bhqe', p_own, v_own.astype(f32)))
        return out.astype(qc.dtype)

    out = lax.map(attend, (jnp.arange(nq), q_ch, idx_ch, valid_ch))
    out = jnp.moveaxis(out, 0, 2).reshape(bsz, H, seq, dh)
    out = out.transpose(0, 2, 1, 3).reshape(bsz, seq, D_MODEL)
    return out @ w_out


def conv_ffn(xn, w_up, conv_w, conv_b, w_down):
    seq = xn.shape[1]
    h = xn @ w_up
    hp = jnp.pad(h, ((0, 0), (CONV_WIDTH - 1, 0), (0, 0)))
    h = conv_b + sum(conv_w[j] * hp[:, j:j + seq] for j in range(CONV_WIDTH))
    gate, up = jnp.split(h, 2, axis=-1)
    return (jax.nn.silu(gate) * up) @ w_down


def setup_inputs(seed: int = 0) -> dict:
    key = jax.random.key(seed)
    ks = jax.random.split(key, 16)
    f32 = jnp.float32
    nrm = jax.random.normal
    D, F2 = D_MODEL, 2 * D_FF
    x = nrm(ks[0], (BATCH, SEQ, D), f32)
    norm_mix = 1.0 + 0.02 * nrm(ks[1], (DEPTH, D), f32)
    norm_ffn = 1.0 + 0.02 * nrm(ks[2], (DEPTH, D), f32)
    a_w_in = nrm(ks[3], (N_A, D, ML_IN_COLS), f32) * D ** -0.5
    kb1, kb2 = jax.random.split(ks[4])
    a_gate_bias = jnp.concatenate([
        0.1 * nrm(kb1, (N_A, ML_HEADS), f32),
        3.0 + 0.1 * nrm(kb2, (N_A, ML_HEADS), f32)], axis=-1)
    a_head_norm = 1.0 + 0.02 * nrm(ks[5], (N_A, D), f32)
    a_w_out = nrm(ks[6], (N_A, D, D), f32) * D ** -0.5
    b_w_qkv = nrm(ks[7], (N_B, D, 3 * D), f32) * D ** -0.5
    b_w_out = nrm(ks[8], (N_B, D, D), f32) * D ** -0.5
    ffn_w_up = nrm(ks[9], (DEPTH, D, F2), f32) * D ** -0.5
    ffn_conv_w = nrm(ks[10], (DEPTH, CONV_WIDTH, F2), f32) * CONV_WIDTH ** -0.5
    ffn_conv_b = 0.01 * nrm(ks[11], (DEPTH, F2), f32)
    ffn_w_down = nrm(ks[12], (DEPTH, D_FF, D), f32) * D_FF ** -0.5
    final_norm = 1.0 + 0.02 * nrm(ks[13], (D,), f32)
    return {"x": x, "norm_mix": norm_mix, "norm_ffn": norm_ffn,
            "a_w_in": a_w_in, "a_gate_bias": a_gate_bias, "a_head_norm": a_head_norm,
            "a_w_out": a_w_out, "b_w_qkv": b_w_qkv, "b_w_out": b_w_out,
            "ffn_w_up": ffn_w_up, "ffn_conv_w": ffn_conv_w, "ffn_conv_b": ffn_conv_b,
            "ffn_w_down": ffn_w_down, "final_norm": final_norm}


def reference(x, norm_mix, norm_ffn, a_w_in, a_gate_bias, a_head_norm, a_w_out,
              b_w_qkv, b_w_out, ffn_w_up, ffn_conv_w, ffn_conv_b, ffn_w_down, final_norm):
    for i in range(DEPTH):
        h = rmsnorm(x, norm_mix[i])
        j = i // N_MIXERS
        if i % N_MIXERS == 0:
            x = x + mlstm_mixer(h, a_w_in[j], a_gate_bias[j], a_head_norm[j], a_w_out[j])
        else:
            x = x + moba_mixer(h, b_w_qkv[j], b_w_out[j])
        h = rmsnorm(x, norm_ffn[i])
        x = x + conv_ffn(h, ffn_w_up[i], ffn_conv_w[i], ffn_conv_b[i], ffn_w_down[i])
    return rmsnorm(x, final_norm)
```

```cpp
#include <hip/hip_runtime.h>
#include <cstdio>
#include <cstdint>
namespace pg8 {
#define PG8_LAS __attribute__((address_space(3)))
typedef unsigned short bf16_t;
typedef short bf16x8 __attribute__((ext_vector_type(8)));
typedef float f32x4 __attribute__((ext_vector_type(4)));
typedef unsigned u32x4 __attribute__((ext_vector_type(4)));
constexpr int BM = 256, BK = 64, HALF = 128, HTB = HALF * BK * 2  , STAGE_BYTES = 8 * HTB, NXCD = 8, WGM = 8;

__host__ __device__ __forceinline__ int lds_byte(int r, int c) { const int st = (r >> 4) * 2 + (c >> 5), rr = r & 15, cc = c & 31, ob = rr * 64 + cc * 2; return st * 1024 + (ob ^ (((ob >> 9) & 1) << 5)); }
__host__ __device__ __forceinline__ void stage_rc(int b, int& R, int& C) { const int st = b / 1024, sb = b % 1024, swz = sb ^ (((sb >> 9) & 1) << 5); R = (st >> 1) * 16 + swz / 64; C = (st & 1) * 32 + (swz % 64) / 2; }
__host__ __device__ __forceinline__ int perm32(int rho) { const int n = rho >> 4, i = rho & 15; return 8 * (i >> 2) + 4 * n + (i & 3); }

struct Unit { int pm, pn; };
struct Gemm { const bf16_t* A; const bf16_t* Bt; int M, N, K; };

struct StaticOrder {
    int nM, nN, nwg, G, c;
    __host__ __device__ void init(int M, int N, int G_, int c_) { nM = M / BM; nN = N / BM; nwg = nM * nN; G = G_; c = c_; }
    __host__ __device__ bool next(int i, Unit& u) const {
        const long L = (long)i * G + c; if (L >= nwg) return false;
        int wgid = (int)L; { const int q = nwg / NXCD, r = nwg % NXCD, xcd = wgid % NXCD, off = wgid / NXCD; wgid = (xcd < r ? xcd * (q + 1) : r * (q + 1) + (xcd - r) * q) + off; }
        const int nig = WGM * nN, gid = wgid / nig, fm = gid * WGM, gsz = (nM - fm) < WGM ? (nM - fm) : WGM;
        u.pm = fm + ((wgid % nig) % gsz); u.pn = (wgid % nig) / gsz; return true;
    }
    __device__ __forceinline__ void a_ready(const Unit&) const {}
    __device__ __forceinline__ void done(const Unit&) const {}
};
__device__ __forceinline__ unsigned cvt_pk_bf16(float lo, float hi) { unsigned r; asm volatile("v_cvt_pk_bf16_f32 %0, %1, %2" : "=v"(r) : "v"(lo), "v"(hi)); return r; }
typedef float f32x2 __attribute__((ext_vector_type(2)));
template <class Epi, class Sched, bool ALIGN_EPI = false, bool SP2 = false>
__device__ __forceinline__ void gemm_phase(PG8_LAS unsigned char* lds, const Gemm g, const Sched& S, const Epi& E) {
    const int tid = threadIdx.x, wid = __builtin_amdgcn_readfirstlane(tid >> 6), lane = tid & 63, wr = wid >> 2, wc = wid & 3, fr = lane & 15, fq = lane >> 4;
    const int K = g.K, nt = K / BK;
    unsigned voffA[2], voffB[2];
#pragma unroll
    for (int i = 0; i < 2; ++i) { int R, C; stage_rc(tid * 16 + i * 8192, R, C); const int Rb = Epi::PERM ? ((R & ~31) + perm32(R & 31)) : R;
        voffA[i] = (unsigned)(R * K + C) * 2u; voffB[i] = (unsigned)(Rb * K + C) * 2u; }
    const size_t kstep = (size_t)(BK * 2);
    const size_t hstep = (size_t)HALF * K * 2;
    const size_t tstep = 2 * hstep;
    const unsigned ldsw = (unsigned)wid * 1024u;
    const int aoff = lds_byte(wr * 64 + fr, fq * 8), boff = lds_byte(wc * 32 + fr, fq * 8);
#define PG8_SA(b, h) (((b) * 2 + (h)) * HTB)
#define PG8_SB(b, h) ((4 + (b) * 2 + (h)) * HTB)
#define PG8_STAGE(bufoff, gbase, voff) do { _Pragma("unroll") for (int _i = 0; _i < 2; ++_i) \
        __builtin_amdgcn_global_load_lds((const unsigned*)((const char*)(gbase) + (voff)[_i]), (PG8_LAS unsigned*)(lds + (bufoff) + ldsw + _i * 8192), 16, 0, 0); } while (0)
#define PG8_LDA(dst, b, h) do { _Pragma("unroll") for (int m = 0; m < 4; ++m) _Pragma("unroll") for (int k = 0; k < 2; ++k) dst[m][k] = *(const PG8_LAS bf16x8*)(lds + PG8_SA(b, h) + aoff + m * 2048 + k * 1024); } while (0)
#define PG8_LDB(dst, b, h) do { _Pragma("unroll") for (int n = 0; n < 2; ++n) _Pragma("unroll") for (int k = 0; k < 2; ++k) dst[n][k] = *(const PG8_LAS bf16x8*)(lds + PG8_SB(b, h) + boff + n * 2048 + k * 1024); } while (0)
#define PG8_MMA(ai, bj, At, Bt) do { __builtin_amdgcn_s_setprio(1); _Pragma("unroll") for (int m = 0; m < 4; ++m) _Pragma("unroll") for (int n = 0; n < 2; ++n) _Pragma("unroll") for (int k = 0; k < 2; ++k) \
        acc[ai][bj][m][n] = __builtin_amdgcn_mfma_f32_16x16x32_bf16(Bt[n][k], At[m][k], acc[ai][bj][m][n], 0, 0, 0); __builtin_amdgcn_s_setprio(0); } while (0)
#define PG8_WAIT_V(n) asm volatile("s_waitcnt vmcnt(" #n ")" ::: "memory")
#define PG8_WAIT_L(n) asm volatile("s_waitcnt lgkmcnt(" #n ")" ::: "memory")
#define PG8_BAR __builtin_amdgcn_s_barrier()
#define PG8_SCHED __builtin_amdgcn_sched_barrier(0)
    Unit cur, nxt; int ui = 0;
    if (!S.next(0, cur)) return;
    f32x4 acc[2][2][4][2];
#pragma unroll
    for (int a = 0; a < 2; ++a)
#pragma unroll
        for (int b = 0; b < 2; ++b)
#pragma unroll
            for (int m = 0; m < 4; ++m)
#pragma unroll
                for (int n = 0; n < 2; ++n) acc[a][b][m][n] = (f32x4){0.f, 0.f, 0.f, 0.f};
    bf16x8 At[4][2], B0[2][2], B1[2][2];
    const char* cA = (const char*)g.A + (size_t)cur.pm * tstep; const char* cB = (const char*)g.Bt + (size_t)cur.pn * tstep;
    S.a_ready(cur);
    if constexpr (SP2) {
        PG8_STAGE(PG8_SB(0, 0), cB, voffB); PG8_STAGE(PG8_SB(0, 1), cB + hstep, voffB); PG8_STAGE(PG8_SA(0, 0), cA, voffA); PG8_STAGE(PG8_SA(0, 1), cA + hstep, voffA);
        if (wr == 1) PG8_BAR;
        PG8_WAIT_V(2); PG8_BAR;
        PG8_STAGE(PG8_SB(1, 0), cB + kstep, voffB); PG8_STAGE(PG8_SA(1, 0), cA + kstep, voffA); PG8_STAGE(PG8_SB(1, 1), cB + hstep + kstep, voffB);
        PG8_WAIT_V(6); PG8_BAR;
    } else {
        PG8_STAGE(PG8_SB(0, 0), cB, voffB); PG8_STAGE(PG8_SA(0, 0), cA, voffA); PG8_STAGE(PG8_SB(0, 1), cB + hstep, voffB); PG8_STAGE(PG8_SA(0, 1), cA + hstep, voffA);
        if (wr == 1) PG8_BAR;
        PG8_WAIT_V(4); PG8_BAR;
        PG8_STAGE(PG8_SB(1, 0), cB + kstep, voffB); PG8_STAGE(PG8_SA(1, 0), cA + kstep, voffA); PG8_STAGE(PG8_SB(1, 1), cB + hstep + kstep, voffB);
        PG8_WAIT_V(6); PG8_BAR;
    }
    for (;;) {
        const bool has_next = S.next(ui + 1, nxt);
        const char* nA = has_next ? (const char*)g.A + (size_t)nxt.pm * tstep : cA; const char* nB = has_next ? (const char*)g.Bt + (size_t)nxt.pn * tstep : cB;
        for (int t = 0; t < nt; t += 2) {
            const bool last = (t == nt - 2);
            const char* a1 = cA + (size_t)(t + 1) * kstep;
            const char* a2 = last ? nA : cA + (size_t)(t + 2) * kstep; const char* b2 = last ? nB : cB + (size_t)(t + 2) * kstep;
            const char* a3 = a2 + kstep; const char* b3 = b2 + kstep;
            if (last && has_next) S.a_ready(nxt);
            if constexpr (SP2) {
            PG8_LDB(B0, 0, 0); PG8_LDB(B1, 0, 1); PG8_SCHED; PG8_LDA(At, 0, 0); PG8_STAGE(PG8_SA(1, 1), a1 + hstep, voffA);
            PG8_WAIT_V(8); PG8_WAIT_L(0); PG8_BAR; PG8_MMA(0, 0, At, B0); PG8_MMA(0, 1, At, B1); PG8_BAR; PG8_SCHED;
            PG8_LDA(At, 0, 1); PG8_STAGE(PG8_SB(0, 0), b2, voffB); PG8_STAGE(PG8_SB(0, 1), b2 + hstep, voffB); PG8_STAGE(PG8_SA(0, 0), a2, voffA);
            PG8_WAIT_V(8); PG8_WAIT_L(0); PG8_BAR; PG8_MMA(1, 0, At, B0); PG8_MMA(1, 1, At, B1); PG8_BAR; PG8_SCHED;
            PG8_LDB(B0, 1, 0); PG8_LDB(B1, 1, 1); PG8_SCHED; PG8_LDA(At, 1, 0); PG8_STAGE(PG8_SA(0, 1), a2 + hstep, voffA);
            PG8_WAIT_V(8); PG8_WAIT_L(0); PG8_BAR; PG8_MMA(0, 0, At, B0); PG8_MMA(0, 1, At, B1); PG8_BAR; PG8_SCHED;
            PG8_LDA(At, 1, 1); PG8_STAGE(PG8_SB(1, 0), b3, voffB); PG8_STAGE(PG8_SB(1, 1), b3 + hstep, voffB); PG8_STAGE(PG8_SA(1, 0), a3, voffA);
            PG8_WAIT_V(8); PG8_WAIT_L(0); PG8_BAR; PG8_MMA(1, 0, At, B0); PG8_MMA(1, 1, At, B1); PG8_BAR; PG8_SCHED;
            } else {
            PG8_LDB(B0, 0, 0); PG8_SCHED; PG8_LDA(At, 0, 0); PG8_STAGE(PG8_SA(1, 1), a1 + hstep, voffA);
            PG8_WAIT_L(8); PG8_BAR; PG8_WAIT_L(0); PG8_MMA(0, 0, At, B0); PG8_BAR; PG8_SCHED;
            PG8_LDB(B1, 0, 1); PG8_STAGE(PG8_SB(0, 0), b2, voffB);
            PG8_BAR; PG8_WAIT_L(0); PG8_MMA(0, 1, At, B1); PG8_BAR;
            PG8_LDA(At, 0, 1); PG8_STAGE(PG8_SA(0, 0), a2, voffA);
            PG8_BAR; PG8_WAIT_L(0); PG8_MMA(1, 0, At, B0); PG8_BAR; PG8_SCHED;
            PG8_STAGE(PG8_SB(0, 1), b2 + hstep, voffB);
            PG8_WAIT_V(6); PG8_BAR; PG8_MMA(1, 1, At, B1); PG8_BAR;
            PG8_LDB(B0, 1, 0); PG8_SCHED; PG8_LDA(At, 1, 0); PG8_STAGE(PG8_SA(0, 1), a2 + hstep, voffA);
            PG8_WAIT_L(8); PG8_BAR; PG8_WAIT_L(0); PG8_MMA(0, 0, At, B0); PG8_BAR; PG8_SCHED;
            PG8_LDB(B1, 1, 1); PG8_STAGE(PG8_SB(1, 0), b3, voffB);
            PG8_BAR; PG8_WAIT_L(0); PG8_MMA(0, 1, At, B1); PG8_BAR;
            PG8_LDA(At, 1, 1); PG8_STAGE(PG8_SA(1, 0), a3, voffA);
            PG8_BAR; PG8_WAIT_L(0); PG8_MMA(1, 0, At, B0); PG8_BAR; PG8_SCHED;
            PG8_STAGE(PG8_SB(1, 1), b3 + hstep, voffB);
            PG8_WAIT_V(6); PG8_BAR; PG8_MMA(1, 1, At, B1); PG8_BAR;
            }
        }
        if constexpr (ALIGN_EPI) { if (wr == 0) PG8_BAR; }
        if constexpr (!Epi::AFTER_DRAIN) { E(acc, cur, wr, wc, fr, fq); S.done(cur); }
        if (!has_next) break;
#pragma unroll
        for (int a = 0; a < 2; ++a)
#pragma unroll
            for (int b = 0; b < 2; ++b)
#pragma unroll
                for (int m = 0; m < 4; ++m)
#pragma unroll
                    for (int n = 0; n < 2; ++n) acc[a][b][m][n] = (f32x4){0.f, 0.f, 0.f, 0.f};
        cur = nxt; cA = nA; cB = nB; ++ui;
        if constexpr (ALIGN_EPI) { if (wr == 1) PG8_BAR; }
    }
    PG8_WAIT_V(0);
    if constexpr (!ALIGN_EPI) { if (wr == 0) PG8_BAR; }
    PG8_BAR;
    if constexpr (Epi::AFTER_DRAIN) { E.fused(acc, cur, wr, wc, fr, fq, lds, wid, lane); S.done(cur); }
#undef PG8_SA
#undef PG8_SB
#undef PG8_STAGE
#undef PG8_LDA
#undef PG8_LDB
#undef PG8_MMA
#undef PG8_WAIT_V
#undef PG8_WAIT_L
#undef PG8_BAR
#undef PG8_SCHED
}
typedef int i32x4 __attribute__((ext_vector_type(4)));
template <class Epi, class Sched, bool ALIGN_EPI = false, bool SP2 = false>
__device__ __forceinline__ void gemm_phase_i8(PG8_LAS unsigned char* lds, const Gemm g, const Sched& S, const Epi& E) {
    const int tid = threadIdx.x, wid = __builtin_amdgcn_readfirstlane(tid >> 6), lane = tid & 63, wr = wid >> 2, wc = wid & 3, fr = lane & 15, fq = lane >> 4;
    const int K = g.K, nt = K / BK;
    unsigned voffA[2], voffB[2];
#pragma unroll
    for (int i = 0; i < 2; ++i) { int R, C; stage_rc(tid * 16 + i * 8192, R, C); const int Rb = Epi::PERM ? ((R & ~31) + perm32(R & 31)) : R;
        voffA[i] = (unsigned)(R * K + C) * 2u; voffB[i] = (unsigned)(Rb * K + C) * 2u; }
    const size_t kstep = (size_t)(BK * 2);
    const size_t hstep = (size_t)HALF * K * 2;
    const size_t tstep = 2 * hstep;
    const unsigned ldsw = (unsigned)wid * 1024u;
    const int aoff = lds_byte(wr * 64 + fr, fq * 8), boff = lds_byte(wc * 32 + fr, fq * 8);
#define PG8_SA(b, h) (((b) * 2 + (h)) * HTB)
#define PG8_SB(b, h) ((4 + (b) * 2 + (h)) * HTB)
#define PG8_STAGE(bufoff, gbase, voff) do { _Pragma("unroll") for (int _i = 0; _i < 2; ++_i) \
        __builtin_amdgcn_global_load_lds((const unsigned*)((const char*)(gbase) + (voff)[_i]), (PG8_LAS unsigned*)(lds + (bufoff) + ldsw + _i * 8192), 16, 0, 0); } while (0)
#define PG8_LDA(dst, b, h) do { _Pragma("unroll") for (int m = 0; m < 4; ++m) _Pragma("unroll") for (int k = 0; k < 2; ++k) dst[m][k] = *(const PG8_LAS bf16x8*)(lds + PG8_SA(b, h) + aoff + m * 2048 + k * 1024); } while (0)
#define PG8_LDB(dst, b, h) do { _Pragma("unroll") for (int n = 0; n < 2; ++n) _Pragma("unroll") for (int k = 0; k < 2; ++k) dst[n][k] = *(const PG8_LAS bf16x8*)(lds + PG8_SB(b, h) + boff + n * 2048 + k * 1024); } while (0)
#define PG8_MMA(ai, bj, At, Bt) do { __builtin_amdgcn_s_setprio(1); _Pragma("unroll") for (int m = 0; m < 4; ++m) _Pragma("unroll") for (int n = 0; n < 2; ++n) _Pragma("unroll") for (int k = 0; k < 2; ++k) \
        acc[ai][bj][m][n] = __builtin_amdgcn_mfma_i32_16x16x64_i8(__builtin_bit_cast(i32x4, Bt[n][k]), __builtin_bit_cast(i32x4, At[m][k]), acc[ai][bj][m][n], 0, 0, 0); __builtin_amdgcn_s_setprio(0); } while (0)
#define PG8_WAIT_V(n) asm volatile("s_waitcnt vmcnt(" #n ")" ::: "memory")
#define PG8_WAIT_L(n) asm volatile("s_waitcnt lgkmcnt(" #n ")" ::: "memory")
#define PG8_BAR __builtin_amdgcn_s_barrier()
#define PG8_SCHED __builtin_amdgcn_sched_barrier(0)
    Unit cur, nxt; int ui = 0;
    if (!S.next(0, cur)) return;
    i32x4 acc[2][2][4][2];
#pragma unroll
    for (int a = 0; a < 2; ++a)
#pragma unroll
        for (int b = 0; b < 2; ++b)
#pragma unroll
            for (int m = 0; m < 4; ++m)
#pragma unroll
                for (int n = 0; n < 2; ++n) acc[a][b][m][n] = (i32x4){0, 0, 0, 0};
    bf16x8 At[4][2], B0[2][2], B1[2][2];
    const char* cA = (const char*)g.A + (size_t)cur.pm * tstep; const char* cB = (const char*)g.Bt + (size_t)cur.pn * tstep;
    S.a_ready(cur);
    if constexpr (SP2) {
        PG8_STAGE(PG8_SB(0, 0), cB, voffB); PG8_STAGE(PG8_SB(0, 1), cB + hstep, voffB); PG8_STAGE(PG8_SA(0, 0), cA, voffA); PG8_STAGE(PG8_SA(0, 1), cA + hstep, voffA);
        if (wr == 1) PG8_BAR;
        PG8_WAIT_V(2); PG8_BAR;
        PG8_STAGE(PG8_SB(1, 0), cB + kstep, voffB); PG8_STAGE(PG8_SA(1, 0), cA + kstep, voffA); PG8_STAGE(PG8_SB(1, 1), cB + hstep + kstep, voffB);
        PG8_WAIT_V(6); PG8_BAR;
    } else {
        PG8_STAGE(PG8_SB(0, 0), cB, voffB); PG8_STAGE(PG8_SA(0, 0), cA, voffA); PG8_STAGE(PG8_SB(0, 1), cB + hstep, voffB); PG8_STAGE(PG8_SA(0, 1), cA + hstep, voffA);
        if (wr == 1) PG8_BAR;
        PG8_WAIT_V(4); PG8_BAR;
        PG8_STAGE(PG8_SB(1, 0), cB + kstep, voffB); PG8_STAGE(PG8_SA(1, 0), cA + kstep, voffA); PG8_STAGE(PG8_SB(1, 1), cB + hstep + kstep, voffB);
        PG8_WAIT_V(6); PG8_BAR;
    }
    for (;;) {
        const bool has_next = S.next(ui + 1, nxt);
        const char* nA = has_next ? (const char*)g.A + (size_t)nxt.pm * tstep : cA; const char* nB = has_next ? (const char*)g.Bt + (size_t)nxt.pn * tstep : cB;
        for (int t = 0; t < nt; t += 2) {
            const bool last = (t == nt - 2);
            const char* a1 = cA + (size_t)(t + 1) * kstep;
            const char* a2 = last ? nA : cA + (size_t)(t + 2) * kstep; const char* b2 = last ? nB : cB + (size_t)(t + 2) * kstep;
            const char* a3 = a2 + kstep; const char* b3 = b2 + kstep;
            if (last && has_next) S.a_ready(nxt);
            if constexpr (SP2) {
            PG8_LDB(B0, 0, 0); PG8_LDB(B1, 0, 1); PG8_SCHED; PG8_LDA(At, 0, 0); PG8_STAGE(PG8_SA(1, 1), a1 + hstep, voffA);
            PG8_WAIT_V(8); PG8_WAIT_L(0); PG8_BAR; PG8_MMA(0, 0, At, B0); PG8_MMA(0, 1, At, B1); PG8_BAR; PG8_SCHED;
            PG8_LDA(At, 0, 1); PG8_STAGE(PG8_SB(0, 0), b2, voffB); PG8_STAGE(PG8_SB(0, 1), b2 + hstep, voffB); PG8_STAGE(PG8_SA(0, 0), a2, voffA);
            PG8_WAIT_V(8); PG8_WAIT_L(0); PG8_BAR; PG8_MMA(1, 0, At, B0); PG8_MMA(1, 1, At, B1); PG8_BAR; PG8_SCHED;
            PG8_LDB(B0, 1, 0); PG8_LDB(B1, 1, 1); PG8_SCHED; PG8_LDA(At, 1, 0); PG8_STAGE(PG8_SA(0, 1), a2 + hstep, voffA);
            PG8_WAIT_V(8); PG8_WAIT_L(0); PG8_BAR; PG8_MMA(0, 0, At, B0); PG8_MMA(0, 1, At, B1); PG8_BAR; PG8_SCHED;
            PG8_LDA(At, 1, 1); PG8_STAGE(PG8_SB(1, 0), b3, voffB); PG8_STAGE(PG8_SB(1, 1), b3 + hstep, voffB); PG8_STAGE(PG8_SA(1, 0), a3, voffA);
            PG8_WAIT_V(8); PG8_WAIT_L(0); PG8_BAR; PG8_MMA(1, 0, At, B0); PG8_MMA(1, 1, At, B1); PG8_BAR; PG8_SCHED;
            } else {
            PG8_LDB(B0, 0, 0); PG8_SCHED; PG8_LDA(At, 0, 0); PG8_STAGE(PG8_SA(1, 1), a1 + hstep, voffA);
            PG8_WAIT_L(8); PG8_BAR; PG8_WAIT_L(0); PG8_MMA(0, 0, At, B0); PG8_BAR; PG8_SCHED;
            PG8_LDB(B1, 0, 1); PG8_STAGE(PG8_SB(0, 0), b2, voffB);
            PG8_BAR; PG8_WAIT_L(0); PG8_MMA(0, 1, At, B1); PG8_BAR;
            PG8_LDA(At, 0, 1); PG8_STAGE(PG8_SA(0, 0), a2, voffA);
            PG8_BAR; PG8_WAIT_L(0); PG8_MMA(1, 0, At, B0); PG8_BAR; PG8_SCHED;
            PG8_STAGE(PG8_SB(0, 1), b2 + hstep, voffB);
            PG8_WAIT_V(6); PG8_BAR; PG8_MMA(1, 1, At, B1); PG8_BAR;
            PG8_LDB(B0, 1, 0); PG8_SCHED; PG8_LDA(At, 1, 0); PG8_STAGE(PG8_SA(0, 1), a2 + hstep, voffA);
            PG8_WAIT_L(8); PG8_BAR; PG8_WAIT_L(0); PG8_MMA(0, 0, At, B0); PG8_BAR; PG8_SCHED;
            PG8_LDB(B1, 1, 1); PG8_STAGE(PG8_SB(1, 0), b3, voffB);
            PG8_BAR; PG8_WAIT_L(0); PG8_MMA(0, 1, At, B1); PG8_BAR;
            PG8_LDA(At, 1, 1); PG8_STAGE(PG8_SA(1, 0), a3, voffA);
            PG8_BAR; PG8_WAIT_L(0); PG8_MMA(1, 0, At, B0); PG8_BAR; PG8_SCHED;
            PG8_STAGE(PG8_SB(1, 1), b3 + hstep, voffB);
            PG8_WAIT_V(6); PG8_BAR; PG8_MMA(1, 1, At, B1); PG8_BAR;
            }
        }
        if constexpr (ALIGN_EPI) { if (wr == 0) PG8_BAR; }
        if constexpr (!Epi::AFTER_DRAIN) { E(acc, cur, wr, wc, fr, fq); S.done(cur); }
        if (!has_next) break;
#pragma unroll
        for (int a = 0; a < 2; ++a)
#pragma unroll
            for (int b = 0; b < 2; ++b)
#pragma unroll
                for (int m = 0; m < 4; ++m)
#pragma unroll
                    for (int n = 0; n < 2; ++n) acc[a][b][m][n] = (i32x4){0, 0, 0, 0};
        cur = nxt; cA = nA; cB = nB; ++ui;
        if constexpr (ALIGN_EPI) { if (wr == 1) PG8_BAR; }
    }
    PG8_WAIT_V(0);
    if constexpr (!ALIGN_EPI) { if (wr == 0) PG8_BAR; }
    PG8_BAR;
    if constexpr (Epi::AFTER_DRAIN) { E.fused(acc, cur, wr, wc, fr, fq, lds, wid, lane); S.done(cur); }
#undef PG8_SA
#undef PG8_SB
#undef PG8_STAGE
#undef PG8_LDA
#undef PG8_LDB
#undef PG8_MMA
#undef PG8_WAIT_V
#undef PG8_WAIT_L
#undef PG8_BAR
#undef PG8_SCHED
}
}

#define GAS __attribute__((address_space(1)))
#define LAS __attribute__((address_space(3)))
typedef unsigned short bf16;
typedef unsigned v4u __attribute__((ext_vector_type(4)));
typedef unsigned v2u __attribute__((ext_vector_type(2)));
typedef float f32x4 __attribute__((ext_vector_type(4)));
typedef float f32x2 __attribute__((ext_vector_type(2)));
typedef short bf16x8 __attribute__((ext_vector_type(8)));
typedef GAS unsigned gu32;
#define RLX_AGENT __ATOMIC_RELAXED, __HIP_MEMORY_SCOPE_AGENT
#define LDS_WAIT() asm volatile("s_waitcnt lgkmcnt(0)" ::: "memory")
#define VM_WAIT() asm volatile("s_waitcnt vmcnt(0)" ::: "memory")

#ifndef MK_PER_PHASE
#define MK_PER_PHASE 0
#endif

constexpr int NWAVES = 8, NTHR = 512;
constexpr int BATCH = 2, SEQ = 8192, DM = 4096, MTOK = BATCH * SEQ;
constexpr int NPROJ = 12288, ML_LD = 12304;
constexpr int FF = 11008, F2 = 22016;
constexpr float EPS = 1e-6f;
constexpr int NPHASE = 28;

constexpr size_t MiB = 1u << 20;
constexpr size_t WS_CTL = 0, CTL_ZERO_BYTES = 1 * MiB;
constexpr size_t WS_WIN = 1 * MiB, WS_WG = 97 * MiB, WS_WAO = 98 * MiB, WS_WQKV = 130 * MiB, WS_WBO = 226 * MiB;
constexpr size_t WS_WUP0 = 258 * MiB, WS_WUP1 = 430 * MiB, WS_WDN0 = 602 * MiB, WS_WDN1 = 688 * MiB;
constexpr size_t WS_X = 774 * MiB, WS_XN = 1030 * MiB, WS_HG = 1158 * MiB;
constexpr size_t WS_SS = 1286 * MiB;
constexpr size_t WS_SA = 1290 * MiB;
constexpr size_t WS_FA = 1287 * MiB, WS_FG = 1288 * MiB, WS_FF = 1289 * MiB, WS_SEL = 1291 * MiB, WS_ML = 1293 * MiB;
constexpr size_t WS_BIG = 1309 * MiB;
constexpr size_t WS_GATES = WS_BIG + 912 * MiB;
constexpr size_t WS_PROJ = WS_BIG, WS_UT = WS_BIG + 384 * MiB, WS_ST = WS_BIG + 648 * MiB;
constexpr size_t WS_HC = WS_BIG, WS_ACT = WS_BIG + 688 * MiB;
constexpr size_t WS_PART = WS_BIG + 384 * MiB;
constexpr size_t WS_KM = WS_BIG + 896 * MiB;
constexpr size_t WS_END = WS_BIG + 1032 * MiB;

constexpr int CW_BAR = 4096;
constexpr int CW_WQ = 16384;
constexpr int CW_WMAX_AO = 65536, CW_WMAX_QKV = 69632, CW_WMAX_BO = 81920, CW_WMAX_UP0 = 90112, CW_WMAX_UP1 = 114688, CW_WMAX_DN0 = 139264, CW_WMAX_DN1 = 143360, CW_WMAX_INO = 147456;
constexpr int LDS_BYTES = 155648;
constexpr int MISC_OFF = 155648 - 256;

__device__ __forceinline__ unsigned f2bf(float f) { unsigned u = __builtin_bit_cast(unsigned, f); return (u + 0x7fffu + ((u >> 16) & 1u)) >> 16; }
__device__ __forceinline__ unsigned pk2(float lo, float hi) { return f2bf(lo) | (f2bf(hi) << 16); }
__device__ __forceinline__ float bflo(unsigned x) { return __uint_as_float(x << 16); }
__device__ __forceinline__ float bfhi(unsigned x) { return __uint_as_float(x & 0xffff0000u); }
__device__ __forceinline__ float bf2f(bf16 x) { return __uint_as_float(((unsigned)x) << 16); }
__device__ __forceinline__ float wave_sum(float v) {
#pragma unroll
    for (int o = 1; o < 64; o <<= 1) v += __shfl_xor(v, o);
    return v;
}
__device__ __forceinline__ f32x4 mfma16(bf16x8 a, bf16x8 b, f32x4 c) { return __builtin_amdgcn_mfma_f32_16x16x32_bf16(a, b, c, 0, 0, 0); }
__device__ __forceinline__ int fresh_lane() { int l; asm volatile("v_mbcnt_lo_u32_b32 %0, -1, 0\n\tv_mbcnt_hi_u32_b32 %0, -1, %0" : "=v"(l)); return l; }
template <int CTRL> __device__ __forceinline__ float dppf(float v) { return __builtin_bit_cast(float, __builtin_amdgcn_update_dpp(0, __builtin_bit_cast(int, v), CTRL, 0xF, 0xF, false)); }

#define XB_TMO      128
#define XB_XCNT(j)  (256  + 64 * (j))
#define XB_XSUB(j)  (1280 + 64 * (j))
#define XB_XGEN(j)  (2304 + 64 * (j))
#define XB_TOP      3328
#define XB_TOPGEN   3392
#define XCD_BAR_WORDS 3456
#define XB_SPIN_CAP (1u << 18)
__device__ __forceinline__ unsigned xb_ld(unsigned* p)              { return __hip_atomic_load(p, __ATOMIC_RELAXED, __HIP_MEMORY_SCOPE_AGENT); }
__device__ __forceinline__ unsigned xb_add(unsigned* p, unsigned v) { return __hip_atomic_fetch_add(p, v, __ATOMIC_RELAXED, __HIP_MEMORY_SCOPE_AGENT); }
__device__ __forceinline__ unsigned xb_xcc_id() { return (unsigned)__builtin_amdgcn_s_getreg((3 << 11) | 20) & 0xFu; }
#define XB_SPIN(cond, bar) do { unsigned _sp = 0; while (cond) { __builtin_amdgcn_s_sleep(1); \
    if ((++_sp & 255u) == 0u) { if (xb_ld(&(bar)[XB_TMO])) break; if (_sp > XB_SPIN_CAP) { atomicAdd(&(bar)[XB_TMO], 1u); break; } } } } while (0)
struct XcdBarrier { unsigned* bar; unsigned x; volatile LAS unsigned* st; };
__device__ __forceinline__ XcdBarrier xcd_barrier_post(unsigned* bar, volatile LAS unsigned* st) {
    XcdBarrier b; b.bar = bar; b.x = xb_xcc_id(); b.st = st;
    if (threadIdx.x == 0) (void)xb_add(&bar[XB_XCNT(b.x)], 1u);
    return b;
}
__device__ __forceinline__ void xcd_barrier_complete(unsigned* bar, unsigned x, unsigned& nloc, unsigned& nx) {
    const unsigned G = gridDim.x * gridDim.y * gridDim.z;
    unsigned sum, cnt, mine, sp = 0u;
    for (;;) {
        sum = 0u; cnt = 0u; mine = 0u;
#pragma unroll
        for (unsigned j = 0; j < 16; ++j) { const unsigned c = xb_ld(&bar[XB_XCNT(j)]); sum += c; cnt += (c > 0u) ? 1u : 0u; mine = (j == x) ? c : mine; }
        if (sum == G) break;
        __builtin_amdgcn_s_sleep(1);
        if ((++sp & 255u) == 0u) { if (xb_ld(&bar[XB_TMO])) break; if (sp > XB_SPIN_CAP) { atomicAdd(&bar[XB_TMO], 1u); break; } }
    }
    nloc = mine > 0u ? mine : 1u; nx = cnt > 0u ? cnt : 1u;
}
__device__ __forceinline__ void xcd_barrier(const XcdBarrier& b) {
    asm volatile("s_waitcnt vmcnt(0)" ::: "memory");
    __syncthreads();
    if (threadIdx.x == 0) {
        unsigned* bar = b.bar;
        __builtin_amdgcn_s_waitcnt(0);
        unsigned nloc = b.st[0], nx = b.st[1];
        if (nloc == 0u) { xcd_barrier_complete(bar, b.x, nloc, nx); b.st[0] = nloc; b.st[1] = nx; }
        const unsigned old = xb_add(&bar[XB_XSUB(b.x)], 1u);
        const unsigned gen = old / nloc;
        if (old + 1u == (gen + 1u) * nloc) {
            __builtin_amdgcn_fence(__ATOMIC_RELEASE, "agent");
            asm volatile("s_waitcnt vmcnt(0)" ::: "memory");
            const unsigned og = xb_add(&bar[XB_TOP], 1u);
            const unsigned tg = og / nx;
            if (og + 1u == (tg + 1u) * nx) xb_add(&bar[XB_TOPGEN], 1u);
            else XB_SPIN(xb_ld(&bar[XB_TOPGEN]) == tg, bar);
            __builtin_amdgcn_fence(__ATOMIC_ACQUIRE, "agent");
            xb_add(&bar[XB_XGEN(b.x)], 1u);
            asm volatile("s_waitcnt vmcnt(0)" ::: "memory");
        } else {
            XB_SPIN(xb_ld(&bar[XB_XGEN(b.x)]) == gen, bar);
            __builtin_amdgcn_fence(__ATOMIC_ACQUIRE, "agent");
            asm volatile("s_waitcnt vmcnt(0)" ::: "memory");
        }
    }
    __syncthreads();
}

struct Ctx {
    LAS unsigned char* lds;
    int tid, lane, wave, G, bid;
    const float *x, *norm_mix, *norm_ffn, *a_w_in, *a_gate_bias, *a_head_norm, *a_w_out, *b_w_qkv, *b_w_out, *ffn_w_up, *ffn_conv_w, *ffn_conv_b, *ffn_w_down, *final_norm;
    float* out;
    unsigned* ctl;
    bf16 *Win, *Wg, *Wao, *Wqkv, *Wbo, *Wup0, *Wup1, *Wdn0, *Wdn1;
    float* X; bf16 *XN, *HG;
    float *GATES, *FA, *FG, *FFv, *KM, *ML; int* SEL;
    bf16 *PROJ, *UT, *ST, *HC, *ACT, *PART;
    float *HALO, *HEAD, *SS; bf16* Xb;
    signed char *A8, *Wao8, *Wqkv8, *Wbo8, *Wup08, *Wup18, *Wdn08, *Wdn18, *ACT8, *Win8, *XN8; float* SA;
};

template <bool UPPERM = false>
__device__ __forceinline__ void transpose_item(const float* W, int ldw, int K, int nblk, bf16* WT, LAS float* scr, int item, int lane, const float* gk = nullptr) {
    const int kb = item / nblk, nb = item % nblk, k0 = 64 * kb, n0 = 64 * nb;
    const int n0o = !UPPERM ? n0 : (n0 < FF ? (n0 >> 7) * 256 + (n0 & 127) : ((n0 - FF) >> 7) * 256 + 128 + ((n0 - FF) & 127));
    const float* src = W + (size_t)k0 * ldw + n0 + lane;
    { float tmp[64];
#pragma unroll
      for (int i = 0; i < 64; ++i) tmp[i] = src[(size_t)i * ldw];
#pragma unroll
      for (int i = 0; i < 64; ++i) scr[i * 65 + lane] = tmp[i]; }
    LDS_WAIT(); asm volatile("" ::: "memory");
    const int c = lane & 7;
    f32x4 g0 = {1.f, 1.f, 1.f, 1.f}, g1 = g0;
    if (gk) { g0 = *(const f32x4*)(gk + k0 + 8 * c); g1 = *(const f32x4*)(gk + k0 + 8 * c + 4); }
#pragma unroll
    for (int j = 0; j < 8; ++j) { const int n = (lane >> 3) + 8 * j; const LAS float* s = scr + (8 * c) * 65 + n;
        v4u o; o.x = pk2(s[0 * 65] * g0.x, s[1 * 65] * g0.y); o.y = pk2(s[2 * 65] * g0.z, s[3 * 65] * g0.w); o.z = pk2(s[4 * 65] * g1.x, s[5 * 65] * g1.y); o.w = pk2(s[6 * 65] * g1.z, s[7 * 65] * g1.w);
        *(v4u*)(WT + (size_t)(n0o + n) * K + k0 + 8 * c) = o; }
    LDS_WAIT(); asm volatile("" ::: "memory");
}
__device__ __forceinline__ void rms_row_bf16(const float* xrow, const float* g, bf16* orow, int lane) {
    const f32x4* xr = (const f32x4*)xrow + lane; const f32x4* gr = (const f32x4*)g + lane;
    f32x4 v[16]; float s = 0.f;
#pragma unroll
    for (int j = 0; j < 16; ++j) { v[j] = xr[64 * j]; s += (v[j].x * v[j].x + v[j].y * v[j].y) + (v[j].z * v[j].z + v[j].w * v[j].w); }
    const float rstd = 1.0f / sqrtf(wave_sum(s) * (1.0f / DM) + EPS);
    v2u* o8 = (v2u*)orow + lane;
#pragma unroll
    for (int j = 0; j < 16; ++j) { const f32x4 gv = gr[64 * j]; v2u o; o.x = pk2(v[j].x * rstd * gv.x, v[j].y * rstd * gv.y); o.y = pk2(v[j].z * rstd * gv.z, v[j].w * rstd * gv.w); o8[64 * j] = o; }
}
__device__ __forceinline__ void rms_row_f32(const float* xrow, const float* g, float* orow, int lane) {
    const f32x4* xr = (const f32x4*)xrow + lane; const f32x4* gr = (const f32x4*)g + lane;
    f32x4 v[16]; float s = 0.f;
#pragma unroll
    for (int j = 0; j < 16; ++j) { v[j] = xr[64 * j]; s += (v[j].x * v[j].x + v[j].y * v[j].y) + (v[j].z * v[j].z + v[j].w * v[j].w); }
    const float rstd = 1.0f / sqrtf(wave_sum(s) * (1.0f / DM) + EPS);
    f32x4* o = (f32x4*)orow + lane;
#pragma unroll
    for (int j = 0; j < 16; ++j) { const f32x4 gv = gr[64 * j]; o[64 * j] = v[j] * rstd * gv; }
}
__device__ __forceinline__ void rms_row_bf16_to_f32(const bf16* xrow, const float* g, float* orow, int lane) {
    const v4u* xr = (const v4u*)xrow + lane; const f32x4* gr = (const f32x4*)g + 2 * lane;
    float v[8][8]; float s = 0.f;
#pragma unroll
    for (int j = 0; j < 8; ++j) { const v4u x = xr[64 * j]; v[j][0] = bflo(x.x); v[j][1] = bfhi(x.x); v[j][2] = bflo(x.y); v[j][3] = bfhi(x.y); v[j][4] = bflo(x.z); v[j][5] = bfhi(x.z); v[j][6] = bflo(x.w); v[j][7] = bfhi(x.w);
#pragma unroll
        for (int k = 0; k < 8; ++k) s += v[j][k] * v[j][k]; }
    const float rstd = 1.0f / sqrtf(wave_sum(s) * (1.0f / DM) + EPS);
    f32x4* o = (f32x4*)orow + 2 * lane;
#pragma unroll
    for (int j = 0; j < 8; ++j) { const f32x4 g0 = gr[128 * j], g1 = gr[128 * j + 1];
        o[128 * j] = (f32x4){v[j][0] * rstd * g0.x, v[j][1] * rstd * g0.y, v[j][2] * rstd * g0.z, v[j][3] * rstd * g0.w};
        o[128 * j + 1] = (f32x4){v[j][4] * rstd * g1.x, v[j][5] * rstd * g1.y, v[j][6] * rstd * g1.z, v[j][7] * rstd * g1.w}; }
}
__device__ __forceinline__ void rms_row_bf16_i8(const float* xrow, const float* g, bf16* orow, signed char* qrow, float* sa, int lane) {
    const f32x4* xr = (const f32x4*)xrow + lane; const f32x4* gr = (const f32x4*)g + lane;
    f32x4 v[16]; float s = 0.f;
#pragma unroll
    for (int j = 0; j < 16; ++j) { v[j] = xr[64 * j]; s += (v[j].x * v[j].x + v[j].y * v[j].y) + (v[j].z * v[j].z + v[j].w * v[j].w); }
    const float rstd = 1.0f / sqrtf(wave_sum(s) * (1.0f / DM) + EPS);
    float mx = 0.f;
#pragma unroll
    for (int j = 0; j < 16; ++j) { v[j] = v[j] * rstd * gr[64 * j]; mx = fmaxf(mx, fmaxf(fmaxf(fabsf(v[j].x), fabsf(v[j].y)), fmaxf(fabsf(v[j].z), fabsf(v[j].w)))); }
#pragma unroll
    for (int o = 1; o < 64; o <<= 1) mx = fmaxf(mx, __shfl_xor(mx, o));
    mx = fmaxf(mx, 1e-30f); const float inv = 127.0f / mx;
    if (lane == 0) *sa = mx * (1.0f / 127.0f);
    v2u* o8 = (v2u*)orow + lane; unsigned* q4 = (unsigned*)qrow + lane;
#pragma unroll
    for (int j = 0; j < 16; ++j) { v2u o; o.x = pk2(v[j].x, v[j].y); o.y = pk2(v[j].z, v[j].w); o8[64 * j] = o;
        const int a0 = (int)__builtin_rintf(v[j].x * inv), a1 = (int)__builtin_rintf(v[j].y * inv), a2 = (int)__builtin_rintf(v[j].z * inv), a3 = (int)__builtin_rintf(v[j].w * inv);
        q4[64 * j] = (unsigned)(a0 & 255) | ((unsigned)(a1 & 255) << 8) | ((unsigned)(a2 & 255) << 16) | ((unsigned)(a3 & 255) << 24); }
}
__device__ __forceinline__ void phase_norm_bf16(const Ctx& C0, const float* src, const float* g, bf16* dst) {
    Ctx C = C0; C.lane = fresh_lane(); C.tid = C.wave * 64 + C.lane;
    const int gw = C.bid * NWAVES + C.wave, NGW = C.G * NWAVES;
    for (int m = gw; m < MTOK; m += NGW) rms_row_bf16_i8(src + (size_t)m * DM, g, dst + (size_t)m * DM, C.XN8 + (size_t)m * DM, C.SA + m, C.lane);
}
template <bool UPPERM = false>
__device__ __forceinline__ void wmax_item(const float* W, int ldw, int nblk, unsigned* wmax, int item, int lane, const float* gk) {
    const int kb = item / nblk, nb = item % nblk, k0 = 64 * kb, n0 = 64 * nb;
    const int n0o = !UPPERM ? n0 : (n0 < FF ? (n0 >> 7) * 256 + (n0 & 127) : ((n0 - FF) >> 7) * 256 + 128 + ((n0 - FF) & 127));
    const float* src = W + (size_t)k0 * ldw + n0 + lane; float m = 0.f;
    { float tmp[64];
#pragma unroll
      for (int i = 0; i < 64; ++i) tmp[i] = src[(size_t)i * ldw];
#pragma unroll
      for (int i = 0; i < 64; ++i) m = fmaxf(m, fabsf(tmp[i] * (gk ? gk[k0 + i] : 1.0f))); }
    atomicMax(wmax + n0o + lane, __float_as_uint(m));
}
__device__ __forceinline__ unsigned pack4_i8(float a, float b, float c, float d) {
    const int a0 = (int)__builtin_rintf(a), a1 = (int)__builtin_rintf(b), a2 = (int)__builtin_rintf(c), a3 = (int)__builtin_rintf(d);
    return (unsigned)(a0 & 255) | ((unsigned)(a1 & 255) << 8) | ((unsigned)(a2 & 255) << 16) | ((unsigned)(a3 & 255) << 24);
}
template <bool UPPERM = false>
__device__ __forceinline__ void quant_item(const float* W, int ldw, int K, int nblk, signed char* WT, const unsigned* wmax, int item, int lane, const float* gk) {
    const int kb = item / nblk, nb = item % nblk, k0 = 128 * kb, n0 = 64 * nb;
    const int n0o = !UPPERM ? n0 : (n0 < FF ? (n0 >> 7) * 256 + (n0 & 127) : ((n0 - FF) >> 7) * 256 + 128 + ((n0 - FF) & 127));
    const float inv = 127.0f / fmaxf(__uint_as_float(wmax[n0o + lane]), 1e-30f);
    const float* src = W + (size_t)k0 * ldw + n0;
    signed char* dst = WT + (size_t)(n0o + lane) * K + k0;
#pragma unroll
    for (int hb = 0; hb < 2; ++hb) { float v[64];
#pragma unroll
        for (int i = 0; i < 64; ++i) v[i] = (src + (size_t)(64 * hb + i) * ldw)[lane];
#pragma unroll
        for (int i = 0; i < 64; ++i) v[i] *= (gk ? gk[k0 + 64 * hb + i] : 1.0f) * inv;
#pragma unroll
        for (int c = 0; c < 4; ++c) { v4u w; w.x = pack4_i8(v[16 * c], v[16 * c + 1], v[16 * c + 2], v[16 * c + 3]); w.y = pack4_i8(v[16 * c + 4], v[16 * c + 5], v[16 * c + 6], v[16 * c + 7]);
            w.z = pack4_i8(v[16 * c + 8], v[16 * c + 9], v[16 * c + 10], v[16 * c + 11]); w.w = pack4_i8(v[16 * c + 12], v[16 * c + 13], v[16 * c + 14], v[16 * c + 15]);
            *(v4u*)(dst + 64 * hb + 16 * c) = w; } }
}
__device__ __forceinline__ void fwht_xlane(float& x, int m, int lane) { const float p = __shfl_xor(x, m); x = (lane & m) ? (p - x) : (x + p); }
template <int M> __device__ __forceinline__ float dpp_xor(float x, int lane) {
    if (M == 1) return dppf<0xB1>(x);
    if (M == 2) return dppf<0x4E>(x);
    if (M == 8) return dppf<0x128>(x);
    const float dn4 = dppf<0x124>(x), up4 = dppf<0x12C>(x);
    return (lane & 4) ? dn4 : up4;
}
template <int M> __device__ __forceinline__ void fwht_dpp(float& x, int lane, float sgn) { x = fmaf(x, sgn, dpp_xor<M>(x, lane)); }
__device__ __forceinline__ void dn_load_rotate(const float* W, int item, int lane, float (&v)[128], int& kb, int& n0) {
    kb = item >> 6; n0 = 64 * (item & 63);
    const float* src = W + (size_t)(128 * kb) * DM + n0;
#pragma unroll
    for (int hb = 0; hb < 2; ++hb)
#pragma unroll
        for (int i = 0; i < 64; ++i) v[64 * hb + i] = (src + (size_t)(64 * hb + i) * DM)[lane];
    __builtin_amdgcn_sched_barrier(0);
#pragma unroll
    for (int st = 1; st < 128; st <<= 1)
#pragma unroll
        for (int i = 0; i < 128; ++i) if (!(i & st)) { const float a = v[i], b = v[i | st]; v[i] = a + b; v[i | st] = a - b; }
#pragma unroll
    for (int q = 0; q < 128; ++q) v[q] *= (1.0f / 128.0f);
    __builtin_amdgcn_sched_barrier(0);
}
__device__ __forceinline__ void dn_wmax_item(const float* W, unsigned* wmax, int item, int lane) {
    float v[128]; int kb, n0; dn_load_rotate(W, item, lane, v, kb, n0);
    float m = 0.f;
#pragma unroll
    for (int q = 0; q < 128; ++q) m = fmaxf(m, fabsf(v[q]));
    atomicMax(wmax + n0 + lane, __float_as_uint(m));
}
__device__ __forceinline__ void dn_quant_item(const float* W, signed char* WT, const unsigned* wmax, int item, int lane) {
    float v[128]; int kb, n0; dn_load_rotate(W, item, lane, v, kb, n0);
    const float inv = 127.0f / fmaxf(__uint_as_float(wmax[n0 + lane]), 1e-30f);
    signed char* dst = WT + (size_t)(n0 + lane) * FF + 128 * kb;
#pragma unroll
    for (int c = 0; c < 8; ++c) { v4u w; w.x = pack4_i8(v[16 * c] * inv, v[16 * c + 1] * inv, v[16 * c + 2] * inv, v[16 * c + 3] * inv); w.y = pack4_i8(v[16 * c + 4] * inv, v[16 * c + 5] * inv, v[16 * c + 6] * inv, v[16 * c + 7] * inv);
        w.z = pack4_i8(v[16 * c + 8] * inv, v[16 * c + 9] * inv, v[16 * c + 10] * inv, v[16 * c + 11] * inv); w.w = pack4_i8(v[16 * c + 12] * inv, v[16 * c + 13] * inv, v[16 * c + 14] * inv, v[16 * c + 15] * inv);
        *(v4u*)(dst + 16 * c) = w; }
}
__device__ __forceinline__ void phase_quant_act(const Ctx& C0) {
    Ctx C = C0; C.lane = fresh_lane(); C.tid = C.wave * 64 + C.lane;
    const int l = C.lane, w = C.wave, pr = w >> 1, hf = w & 1;
    const float sg1 = (l & 1) ? -1.f : 1.f, sg2 = (l & 2) ? -1.f : 1.f, sg4 = (l & 4) ? -1.f : 1.f, sg8 = (l & 8) ? -1.f : 1.f;
    LAS float* mxs = (LAS float*)C.lds;
    int par = 0;
    for (int m0 = C.bid * 4; m0 < MTOK; m0 += C.G * 4, par ^= 1) {
        const int m = m0 + pr;
        const v4u* xr = (const v4u*)(C.ACT + (size_t)m * FF) + l;
        v4u x[11];
#pragma unroll
        for (int t = 0; t < 11; ++t) { const int c = 64 * (11 * hf + t) + l; x[t] = (c < FF / 8) ? xr[64 * (11 * hf + t)] : (v4u){0u, 0u, 0u, 0u}; }
        float v[11][8]; float mx = 0.f;
#pragma unroll
        for (int t = 0; t < 11; ++t) {
            v[t][0] = bflo(x[t].x); v[t][1] = bfhi(x[t].x); v[t][2] = bflo(x[t].y); v[t][3] = bfhi(x[t].y); v[t][4] = bflo(x[t].z); v[t][5] = bfhi(x[t].z); v[t][6] = bflo(x[t].w); v[t][7] = bfhi(x[t].w);
#pragma unroll
            for (int st = 1; st < 8; st <<= 1)
#pragma unroll
                for (int i = 0; i < 8; ++i) if (!(i & st)) { const float a = v[t][i], b = v[t][i | st]; v[t][i] = a + b; v[t][i | st] = a - b; }
#pragma unroll
            for (int i = 0; i < 8; ++i) { fwht_dpp<1>(v[t][i], l, sg1); fwht_dpp<2>(v[t][i], l, sg2); fwht_dpp<4>(v[t][i], l, sg4); fwht_dpp<8>(v[t][i], l, sg8); mx = fmaxf(mx, fabsf(v[t][i])); }
        }
#pragma unroll
        for (int o = 1; o < 64; o <<= 1) mx = fmaxf(mx, __shfl_xor(mx, o));
        if (l == 0) mxs[par * 8 + w] = mx;
        __syncthreads();
        mx = fmaxf(fmaxf(mxs[par * 8 + (w & 6)], mxs[par * 8 + (w | 1)]), 1e-30f);
        const float inv = 127.0f / mx;
        if (l == 0 && hf == 0) C.SA[m] = mx * (1.0f / 127.0f);
        v2u* o8 = (v2u*)(C.ACT8 + (size_t)m * FF) + l;
#pragma unroll
        for (int t = 0; t < 11; ++t) { const int tt = 11 * hf + t;
            v2u o; o.x = pack4_i8(v[t][0] * inv, v[t][1] * inv, v[t][2] * inv, v[t][3] * inv); o.y = pack4_i8(v[t][4] * inv, v[t][5] * inv, v[t][6] * inv, v[t][7] * inv);
            if (64 * tt + l < FF / 8) o8[64 * tt] = o; }
    }
}
__device__ __forceinline__ void phase_quant_weights(const Ctx& C0) {
    Ctx C = C0; C.lane = fresh_lane(); C.tid = C.wave * 64 + C.lane;
    const int gw = C.bid * NWAVES + C.wave, NGW = C.G * NWAVES;
    constexpr int J_DN = 86 * 64;
    for (int it = gw; it < 2 * J_DN; it += NGW) {
        if (it < J_DN) dn_quant_item(C.ffn_w_down, C.Wdn08, C.ctl + CW_WMAX_DN0, it, C.lane);
        else dn_quant_item(C.ffn_w_down + (size_t)FF * DM, C.Wdn18, C.ctl + CW_WMAX_DN1, it - J_DN, C.lane);
    }
}
template <bool NORM>
__device__ __forceinline__ void phase_quant_rows(const Ctx& C0, const bf16* src, signed char* dst, float* SA) {
    Ctx C = C0; C.lane = fresh_lane(); C.tid = C.wave * 64 + C.lane;
    const int gw = C.bid * NWAVES + C.wave, NGW = C.G * NWAVES, l = C.lane;
    for (int m = gw; m < MTOK; m += NGW) {
        const v4u* xr = (const v4u*)(src + (size_t)m * DM) + l;
        v4u x[8]; float mx = 0.f, ss = 0.f;
#pragma unroll
        for (int j = 0; j < 8; ++j) x[j] = xr[64 * j];
#pragma unroll
        for (int j = 0; j < 8; ++j) {
            const float e0 = bflo(x[j].x), e1 = bfhi(x[j].x), e2 = bflo(x[j].y), e3 = bfhi(x[j].y), e4 = bflo(x[j].z), e5 = bfhi(x[j].z), e6 = bflo(x[j].w), e7 = bfhi(x[j].w);
            mx = fmaxf(mx, fmaxf(fmaxf(fabsf(e0), fabsf(e1)), fmaxf(fabsf(e2), fabsf(e3))));
            mx = fmaxf(mx, fmaxf(fmaxf(fabsf(e4), fabsf(e5)), fmaxf(fabsf(e6), fabsf(e7))));
            if (NORM) ss += ((e0 * e0 + e1 * e1) + (e2 * e2 + e3 * e3)) + ((e4 * e4 + e5 * e5) + (e6 * e6 + e7 * e7)); }
#pragma unroll
        for (int o = 1; o < 64; o <<= 1) mx = fmaxf(mx, __shfl_xor(mx, o));
        if (NORM) ss = wave_sum(ss);
        mx = fmaxf(mx, 1e-30f);
        const float inv = 127.0f / mx;
        if (l == 0) SA[m] = NORM ? mx * (1.0f / 127.0f) / sqrtf(ss * (1.0f / DM) + EPS) : mx * (1.0f / 127.0f);
        v2u* o8 = (v2u*)(dst + (size_t)m * DM) + l;
#pragma unroll
        for (int j = 0; j < 8; ++j) {
            const int a0 = (int)__builtin_rintf(bflo(x[j].x) * inv), a1 = (int)__builtin_rintf(bfhi(x[j].x) * inv), a2 = (int)__builtin_rintf(bflo(x[j].y) * inv), a3 = (int)__builtin_rintf(bfhi(x[j].y) * inv);
            const int a4 = (int)__builtin_rintf(bflo(x[j].z) * inv), a5 = (int)__builtin_rintf(bfhi(x[j].z) * inv), a6 = (int)__builtin_rintf(bflo(x[j].w) * inv), a7 = (int)__builtin_rintf(bfhi(x[j].w) * inv);
            v2u o; o.x = (unsigned)(a0 & 255) | ((unsigned)(a1 & 255) << 8) | ((unsigned)(a2 & 255) << 16) | ((unsigned)(a3 & 255) << 24);
            o.y = (unsigned)(a4 & 255) | ((unsigned)(a5 & 255) << 8) | ((unsigned)(a6 & 255) << 16) | ((unsigned)(a7 & 255) << 24);
            o8[64 * j] = o; }
    }
}
template <bool UPPERM>
__device__ __forceinline__ void colblock_item(const Ctx& C, const float* W, int ldw, signed char* WT, unsigned* wmax_out, int blk) {
    const int l = C.lane, w = C.wave, col = l & 31, par = l >> 5;
    const int n0 = 32 * blk;
    const int n0o = !UPPERM ? n0 : (n0 < FF ? (n0 >> 7) * 256 + (n0 & 127) : ((n0 - FF) >> 7) * 256 + 128 + ((n0 - FF) & 127));
    LAS float* cm = (LAS float*)(C.lds + 135168);
    const LAS float* gs = (const LAS float*)(C.lds + 136192) + par * 2048 + 256 * w;
    const float* src = W + (size_t)(512 * w) * ldw + n0;
    const size_t loff = (size_t)par * ldw + col;
    float m = 0.f;
#pragma unroll 1
    for (int b = 0; b < 4; ++b) {
        float v[64];
#pragma unroll
        for (int i = 0; i < 64; ++i) v[i] = (src + (size_t)(128 * b + 2 * i) * ldw)[loff];
#pragma unroll
        for (int i = 0; i < 64; i += 4) { const f32x4 g4 = *(const LAS f32x4*)(gs + 64 * b + i);
            m = fmaxf(m, fmaxf(fmaxf(fabsf(v[i] * g4.x), fabsf(v[i + 1] * g4.y)), fmaxf(fabsf(v[i + 2] * g4.z), fabsf(v[i + 3] * g4.w)))); }
    }
    m = fmaxf(m, __shfl_xor(m, 32));
    __syncthreads();
    if (par == 0) cm[w * 32 + col] = m;
    __syncthreads();
    float cmx = cm[col];
#pragma unroll
    for (int q = 1; q < 8; ++q) cmx = fmaxf(cmx, cm[q * 32 + col]);
    if (w == 0 && par == 0) wmax_out[n0o + col] = __float_as_uint(cmx);
    const float inv = 127.0f / fmaxf(cmx, 1e-30f);
    signed char* dst = WT + (size_t)(n0o + col) * DM + 512 * w;
#pragma unroll 1
    for (int b = 0; b < 4; ++b) {
        float v[64];
#pragma unroll
        for (int i = 0; i < 64; ++i) v[i] = (src + (size_t)(128 * b + 2 * i) * ldw)[loff];
        unsigned mb[16];
#pragma unroll
        for (int d = 0; d < 16; ++d) { const f32x4 g4 = *(const LAS f32x4*)(gs + 64 * b + 4 * d);
            mb[d] = pack4_i8(v[4 * d] * g4.x * inv, v[4 * d + 1] * g4.y * inv, v[4 * d + 2] * g4.z * inv, v[4 * d + 3] * g4.w * inv); }
#pragma unroll
        for (int cp = 0; cp < 4; ++cp) {
            const int xm = 2 * cp + par, xo = 2 * cp + 1 - par;
            const unsigned s0 = par ? mb[4 * cp] : mb[4 * cp + 2], s1 = par ? mb[4 * cp + 1] : mb[4 * cp + 3];
            const unsigned k0 = par ? mb[4 * cp + 2] : mb[4 * cp], k1 = par ? mb[4 * cp + 3] : mb[4 * cp + 1];
            const unsigned r0 = (unsigned)__shfl_xor((int)s0, 32), r1 = (unsigned)__shfl_xor((int)s1, 32);
            const unsigned e0 = par ? r0 : k0, e1 = par ? r1 : k1, o0 = par ? k0 : r0, o1 = par ? k1 : r1;
            v4u ov; ov.x = __builtin_amdgcn_perm(o0, e0, 0x05010400u); ov.y = __builtin_amdgcn_perm(o0, e0, 0x07030602u);
            ov.z = __builtin_amdgcn_perm(o1, e1, 0x05010400u); ov.w = __builtin_amdgcn_perm(o1, e1, 0x07030602u);
            (void)xo; *(v4u*)(dst + 128 * b + 16 * xm) = ov;
        }
    }
}
__device__ __forceinline__ void colblock_gains(const Ctx& C, const float* g) {
    LAS float* gs = (LAS float*)(C.lds + 136192);
    __syncthreads();
    for (int i = C.tid; i < DM; i += NTHR) gs[(i & 1) * 2048 + (i >> 1)] = g ? g[i] : 1.0f;
    __syncthreads();
}
constexpr int CW_GRP = 20480;
__device__ __forceinline__ void phase_prologue(const Ctx& C0) {
    Ctx C = C0; C.lane = fresh_lane(); C.tid = C.wave * 64 + C.lane;
    LAS float* scr = (LAS float*)(C.lds + C.wave * 16896);
    const int gw = C.bid * NWAVES + C.wave, NGW = C.G * NWAVES;
    constexpr int I_DN = 86 * 64, I_INB = 64 * 128;
    constexpr int NITEMS = I_INB + 2 * I_DN;
    for (int it = gw; it < NITEMS; it += NGW) {
        int r = it;
        if (r < I_INB) { transpose_item(C.a_w_in, ML_LD, DM, 128, C.Win, scr, r, C.lane); continue; } r -= I_INB;
        if (r < I_DN) { dn_wmax_item(C.ffn_w_down, C.ctl + CW_WMAX_DN0, r, C.lane); continue; } r -= I_DN;
        dn_wmax_item(C.ffn_w_down + (size_t)FF * DM, C.ctl + CW_WMAX_DN1, r, C.lane);
    }
    {
        typedef float v2f __attribute__((ext_vector_type(2)));
        constexpr int P_UP = F2 / 128, P_QKV = NPROJ / 128, P_SQ = DM / 128, NP = 2 * P_UP + P_QKV + 3 * P_SQ;
        const int ngroups = C.G >> 3, g = C.bid % ngroups, member = C.bid / ngroups;
        if (member < 8 && ngroups <= 64) {
            const int l = C.lane, w = C.wave, tid = C.tid;
            unsigned* gcnt = C.ctl + CW_GRP + 64 * g;
            LAS float* pm = (LAS float*)(C.lds + 135168);
            LAS float* gtab = (LAS float*)(C.lds + 143360);
            __syncthreads();
            { const int i = tid; gtab[i] = C.norm_ffn[512 * member + i]; gtab[512 + i] = C.norm_ffn[DM + 512 * member + i]; gtab[1024 + i] = C.norm_mix[DM + 512 * member + i]; gtab[1536 + i] = 1.0f; }
            __syncthreads();
            v2f v[64];
#pragma unroll
            for (int j = 0; j < 64; ++j) v[j] = (v2f){0.f, 0.f};
            unsigned n = 0;
            for (int it = g - ngroups; it < NP; it += ngroups) {
                const bool have = it >= 0;
                int r = have ? it : 0, mat;
                if (r < P_UP) mat = 0; else if ((r -= P_UP) < P_UP) mat = 1; else if ((r -= P_UP) < P_QKV) mat = 2; else if ((r -= P_QKV) < P_SQ) mat = 3; else if ((r -= P_SQ) < P_SQ) mat = 4; else { r -= P_SQ; mat = 5; }
                signed char* WT; unsigned* wm;
                if (mat == 0) { WT = C.Wup08; wm = C.ctl + CW_WMAX_UP0; } else if (mat == 1) { WT = C.Wup18; wm = C.ctl + CW_WMAX_UP1; } else if (mat == 2) { WT = C.Wqkv8; wm = C.ctl + CW_WMAX_QKV; }
                else if (mat == 3) { WT = C.Wao8; wm = C.ctl + CW_WMAX_AO; } else if (mat == 4) { WT = C.Wbo8; wm = C.ctl + CW_WMAX_BO; } else { WT = C.Win8; wm = C.ctl + CW_WMAX_INO; }
                const int n0 = 128 * r, n0o = mat >= 2 ? n0 : (n0 < FF ? (n0 >> 7) * 256 : ((n0 - FF) >> 7) * 256 + 128);
                unsigned pc0[32], pc1[32]; float m0 = 0.f, m1 = 0.f;
                if (have) {
                    const LAS float* gs = gtab + 512 * (mat < 3 ? mat : 3) + 64 * w;
#pragma unroll
                    for (int j = 0; j < 64; j += 4) { const f32x4 g4 = *(const LAS f32x4*)(gs + j);
                        const v2f x0 = v[j] * g4.x, x1 = v[j + 1] * g4.y, x2 = v[j + 2] * g4.z, x3 = v[j + 3] * g4.w;
                        m0 = fmaxf(m0, fmaxf(fmaxf(fabsf(x0.x), fabsf(x1.x)), fmaxf(fabsf(x2.x), fabsf(x3.x))));
                        m1 = fmaxf(m1, fmaxf(fmaxf(fabsf(x0.y), fabsf(x1.y)), fmaxf(fabsf(x2.y), fabsf(x3.y))));
                        pc0[j >> 1] = pg8::cvt_pk_bf16(x0.x, x1.x); pc0[(j >> 1) + 1] = pg8::cvt_pk_bf16(x2.x, x3.x);
                        pc1[j >> 1] = pg8::cvt_pk_bf16(x0.y, x1.y); pc1[(j >> 1) + 1] = pg8::cvt_pk_bf16(x2.y, x3.y); }
                } else {
#pragma unroll
                    for (int j = 0; j < 32; ++j) { pc0[j] = 0u; pc1[j] = 0u; }
                }
                if (have) *(LAS v2f*)(pm + w * 128 + 2 * l) = (v2f){m0, m1};
                __syncthreads();
                if (have && w == 0) {
                    v2f mx = *(const LAS v2f*)(pm + 2 * l);
#pragma unroll
                    for (int q = 1; q < 8; ++q) { const v2f t = *(const LAS v2f*)(pm + q * 128 + 2 * l); mx.x = fmaxf(mx.x, t.x); mx.y = fmaxf(mx.y, t.y); }
                    (void)__hip_atomic_fetch_max(wm + n0o + 2 * l, __float_as_uint(mx.x), __ATOMIC_RELAXED, __HIP_MEMORY_SCOPE_AGENT);
                    (void)__hip_atomic_fetch_max(wm + n0o + 2 * l + 1, __float_as_uint(mx.y), __ATOMIC_RELAXED, __HIP_MEMORY_SCOPE_AGENT);
                    asm volatile("s_waitcnt vmcnt(0)" ::: "memory");
                    ++n;
                    if (l == 0) { (void)xb_add(gcnt, 1u); XB_SPIN(xb_ld(gcnt) < 8u * n, C.ctl + CW_BAR); }
                    asm volatile("" ::: "memory");
                    const unsigned u0 = xb_ld(wm + n0o + 2 * l), u1 = xb_ld(wm + n0o + 2 * l + 1);
                    *(LAS v2f*)(pm + 1024 + 2 * l) = (v2f){__uint_as_float(u0), __uint_as_float(u1)};
                }
                { const int itn = it + ngroups;
                  if (itn < NP) {
                      int rn = itn; const float* Wn; int ldn;
                      if (rn < P_UP) { Wn = C.ffn_w_up; ldn = F2; } else if ((rn -= P_UP) < P_UP) { Wn = C.ffn_w_up + (size_t)DM * F2; ldn = F2; } else if ((rn -= P_UP) < P_QKV) { Wn = C.b_w_qkv; ldn = NPROJ; }
                      else if ((rn -= P_QKV) < P_SQ) { Wn = C.a_w_out; ldn = DM; } else if ((rn -= P_SQ) < P_SQ) { Wn = C.b_w_out; ldn = DM; } else { rn -= P_SQ; Wn = C.a_w_in + 8192; ldn = ML_LD; }
                      const float* src = Wn + (size_t)(512 * member + 64 * w) * ldn + 128 * rn + 2 * l;
#pragma unroll
                      for (int j = 0; j < 64; ++j) v[j] = *(const v2f*)(src + (size_t)j * ldn);
                  } }
                __syncthreads();
                if (!have) continue;
                const v2f cc = *(const LAS v2f*)(pm + 1024 + 2 * l);
                const float c0 = cc.x, c1 = cc.y;
                const float i0 = 127.0f / fmaxf(c0, 1e-30f), i1 = 127.0f / fmaxf(c1, 1e-30f);
                signed char* dst = WT + (size_t)(n0o + 2 * l) * DM + 512 * member + 64 * w;
#pragma unroll
                for (int q = 0; q < 4; ++q) { v4u a, b;
                    a.x = pack4_i8(bflo(pc0[8 * q]) * i0, bfhi(pc0[8 * q]) * i0, bflo(pc0[8 * q + 1]) * i0, bfhi(pc0[8 * q + 1]) * i0);
                    a.y = pack4_i8(bflo(pc0[8 * q + 2]) * i0, bfhi(pc0[8 * q + 2]) * i0, bflo(pc0[8 * q + 3]) * i0, bfhi(pc0[8 * q + 3]) * i0);
                    a.z = pack4_i8(bflo(pc0[8 * q + 4]) * i0, bfhi(pc0[8 * q + 4]) * i0, bflo(pc0[8 * q + 5]) * i0, bfhi(pc0[8 * q + 5]) * i0);
                    a.w = pack4_i8(bflo(pc0[8 * q + 6]) * i0, bfhi(pc0[8 * q + 6]) * i0, bflo(pc0[8 * q + 7]) * i0, bfhi(pc0[8 * q + 7]) * i0);
                    b.x = pack4_i8(bflo(pc1[8 * q]) * i1, bfhi(pc1[8 * q]) * i1, bflo(pc1[8 * q + 1]) * i1, bfhi(pc1[8 * q + 1]) * i1);
                    b.y = pack4_i8(bflo(pc1[8 * q + 2]) * i1, bfhi(pc1[8 * q + 2]) * i1, bflo(pc1[8 * q + 3]) * i1, bfhi(pc1[8 * q + 3]) * i1);
                    b.z = pack4_i8(bflo(pc1[8 * q + 4]) * i1, bfhi(pc1[8 * q + 4]) * i1, bflo(pc1[8 * q + 5]) * i1, bfhi(pc1[8 * q + 5]) * i1);
                    b.w = pack4_i8(bflo(pc1[8 * q + 6]) * i1, bfhi(pc1[8 * q + 6]) * i1, bflo(pc1[8 * q + 7]) * i1, bfhi(pc1[8 * q + 7]) * i1);
                    *(v4u*)(dst + 16 * q) = a; *(v4u*)(dst + DM + 16 * q) = b; }
            }
        }
    }
    for (int i = C.bid * NTHR + C.tid; i < 16 * DM; i += C.G * NTHR) { const int k = i >> 4, n = i & 15; C.Wg[(size_t)n * DM + k] = (bf16)f2bf(C.a_w_in[(size_t)k * ML_LD + NPROJ + n]); }
    phase_norm_bf16(C, C.x, C.norm_mix, C.XN);
}

__device__ __forceinline__ size_t hm_off(int which, int b, int h, int t) { return ((size_t)((which * 2 + b) * 32 + h) * SEQ + t) * 128; }
__device__ __forceinline__ void scale_rows_by_rstd(f32x4 (&a)[2][2][4][2], const float* SS, int row0, int fq) {
#pragma unroll
    for (int ai = 0; ai < 2; ++ai)
#pragma unroll
        for (int m = 0; m < 4; ++m) { const f32x4* p = (const f32x4*)(SS + (size_t)(row0 + ai * 128 + m * 16) * 16 + fq * 4);
            const f32x4 s0 = p[0];
            float t = (s0.x + s0.y) + (s0.z + s0.w);
            t += __shfl_xor(t, 16); t += __shfl_xor(t, 32);
            const float rs = 1.0f / sqrtf(t * (1.0f / DM) + EPS);
#pragma unroll
            for (int bj = 0; bj < 2; ++bj)
#pragma unroll
                for (int n = 0; n < 2; ++n) a[ai][bj][m][n] = a[ai][bj][m][n] * rs; }
}
struct EpiResidBf {
    static constexpr bool PERM = true, AFTER_DRAIN = false;
    const float* base32; const bf16* base16; bf16* out; float* SS; LAS unsigned char* hl;
    __device__ __forceinline__ void operator()(const f32x4 (&acc)[2][2][4][2], const pg8::Unit& u, int wr, int wc, int fr, int fq) const {
        const int row0 = u.pm * 256 + wr * 64 + fr, col0 = u.pn * 256 + wc * 32 + 8 * fq;
        LAS float* T = (LAS float*)hl;
#pragma unroll
        for (int ai = 0; ai < 2; ++ai) {
            f32x4 b0[4][2], b1[4][2];
            if (base32) {
#pragma unroll
                for (int m = 0; m < 4; ++m)
#pragma unroll
                    for (int bj = 0; bj < 2; ++bj) { const size_t off = (size_t)(row0 + ai * 128 + m * 16) * DM + col0 + bj * 128; b0[m][bj] = *(const f32x4*)(base32 + off); b1[m][bj] = *(const f32x4*)(base32 + off + 4); }
            } else {
                v4u xb[4][2];
#pragma unroll
                for (int m = 0; m < 4; ++m)
#pragma unroll
                    for (int bj = 0; bj < 2; ++bj) xb[m][bj] = *(const v4u*)(base16 + (size_t)(row0 + ai * 128 + m * 16) * DM + col0 + bj * 128);
#pragma unroll
                for (int m = 0; m < 4; ++m)
#pragma unroll
                    for (int bj = 0; bj < 2; ++bj) { const v4u x = xb[m][bj]; b0[m][bj] = (f32x4){bflo(x.x), bfhi(x.x), bflo(x.y), bfhi(x.y)}; b1[m][bj] = (f32x4){bflo(x.z), bfhi(x.z), bflo(x.w), bfhi(x.w)}; }
            }
#pragma unroll
            for (int m = 0; m < 4; ++m) { const size_t off = (size_t)(row0 + ai * 128 + m * 16) * DM + col0; float ss = 0.f;
#pragma unroll
                for (int bj = 0; bj < 2; ++bj) {
                    const f32x4 v0 = b0[m][bj] + acc[ai][bj][m][0], v1 = b1[m][bj] + acc[ai][bj][m][1];
                    ss += ((v0[0] * v0[0] + v0[1] * v0[1]) + (v0[2] * v0[2] + v0[3] * v0[3])) + ((v1[0] * v1[0] + v1[1] * v1[1]) + (v1[2] * v1[2] + v1[3] * v1[3]));
                    v4u w; w.x = pg8::cvt_pk_bf16(v0[0], v0[1]); w.y = pg8::cvt_pk_bf16(v0[2], v0[3]); w.z = pg8::cvt_pk_bf16(v1[0], v1[1]); w.w = pg8::cvt_pk_bf16(v1[2], v1[3]);
                    *(v4u*)(out + off + bj * 128) = w; }
                ss += __shfl_xor(ss, 16); ss += __shfl_xor(ss, 32);
                if (fq == 0) T[wc * 256 + wr * 64 + fr + ai * 128 + m * 16] = ss; }
        }
        asm volatile("s_waitcnt lgkmcnt(0)" ::: "memory"); __builtin_amdgcn_s_barrier(); asm volatile("" ::: "memory");
        { const int tid = threadIdx.x; if (tid < 256) SS[(size_t)(u.pm * 256 + tid) * 16 + u.pn] = (T[tid] + T[256 + tid]) + (T[512 + tid] + T[768 + tid]); }
        asm volatile("s_waitcnt lgkmcnt(0)" ::: "memory"); __builtin_amdgcn_s_barrier(); asm volatile("" ::: "memory");
    }
};
struct EpiStoreBf16 {
    static constexpr bool PERM = true, AFTER_DRAIN = false;
    bf16* O; int ldc; const float* SS; float* KMH;
    __device__ __forceinline__ void operator()(const f32x4 (&acc)[2][2][4][2], const pg8::Unit& u, int wr, int wc, int fr, int fq) const {
        const int row0 = u.pm * 256 + wr * 64 + fr, col0 = u.pn * 256 + wc * 32 + 8 * fq;
        if (SS) scale_rows_by_rstd(const_cast<f32x4 (&)[2][2][4][2]>(acc), SS, row0, fq);
        if (KMH && u.pn >= 16 && u.pn < 32) {
#pragma unroll
            for (int bj = 0; bj < 2; ++bj)
#pragma unroll
                for (int n = 0; n < 2; ++n) { f32x4 cs = {0.f, 0.f, 0.f, 0.f};
#pragma unroll
                    for (int ai = 0; ai < 2; ++ai)
#pragma unroll
                        for (int m = 0; m < 4; ++m) cs = cs + acc[ai][bj][m][n];
#pragma unroll
                    for (int j = 0; j < 4; ++j) { float v = cs[j]; v += __shfl_xor(v, 1); v += __shfl_xor(v, 2); v += __shfl_xor(v, 4); v += __shfl_xor(v, 8); cs[j] = v; }
                    if (fr == 0) { const int c = 256 * (u.pn - 16) + 128 * bj + 32 * wc + 8 * fq + 4 * n, hh = c >> 7, d = c & 127, bb = u.pm >> 5, nb = u.pm & 31;
                        *(f32x4*)(KMH + (size_t)wr * (64 * 32 * 128) + ((size_t)((bb * 32 + hh) * 32 + nb)) * 128 + d) = cs; } }
        }
#pragma unroll
        for (int ai = 0; ai < 2; ++ai)
#pragma unroll
            for (int m = 0; m < 4; ++m) { bf16* rowp = O + (size_t)(row0 + ai * 128 + m * 16) * ldc + col0;
#pragma unroll
                for (int bj = 0; bj < 2; ++bj) { const f32x4 v0 = acc[ai][bj][m][0], v1 = acc[ai][bj][m][1];
                    v4u w; w.x = pg8::cvt_pk_bf16(v0[0], v0[1]); w.y = pg8::cvt_pk_bf16(v0[2], v0[3]); w.z = pg8::cvt_pk_bf16(v1[0], v1[1]); w.w = pg8::cvt_pk_bf16(v1[2], v1[3]);
                    *(v4u*)(rowp + bj * 128) = w; } }
    }
};
struct EpiResid {
    static constexpr bool PERM = false, AFTER_DRAIN = false;
    const float* base; float* out; int ldc;
    __device__ __forceinline__ void operator()(const f32x4 (&acc)[2][2][4][2], const pg8::Unit& u, int wr, int wc, int fr, int fq) const {
        const int row0 = u.pm * 256 + wr * 64 + fr, col0 = u.pn * 256 + wc * 32 + 4 * fq;
#pragma unroll
        for (int ai = 0; ai < 2; ++ai)
#pragma unroll
            for (int m = 0; m < 4; ++m) { const size_t off = (size_t)(row0 + ai * 128 + m * 16) * ldc + col0;
#pragma unroll
                for (int bj = 0; bj < 2; ++bj)
#pragma unroll
                    for (int n = 0; n < 2; ++n) { const f32x4 bs = *(const f32x4*)(base + off + bj * 128 + n * 16); *(f32x4*)(out + off + bj * 128 + n * 16) = bs + acc[ai][bj][m][n]; } }
    }
};
template <int CTRL> __device__ __forceinline__ float dppf_old(float old, float v) { return __builtin_bit_cast(float, __builtin_amdgcn_update_dpp(__builtin_bit_cast(int, old), __builtin_bit_cast(int, v), CTRL, 0xF, 0xF, false)); }
__device__ __forceinline__ float silu_mul(float g, float u) { return g * __builtin_amdgcn_rcpf(1.0f + __builtin_amdgcn_exp2f(-1.4426950408889634f * g)) * u; }
typedef int i32x4 __attribute__((ext_vector_type(4)));
struct ConvActArgs { bf16* ACT; const float* cw; const float* cb; float* HALO; float* HEAD; LAS unsigned char* hl; };
__device__ __forceinline__ void conv_taps_dma(const ConvActArgs& P, const pg8::Unit& u, int wr, int wc, int fr, int fq) {
    const float* cw = P.cw; const float* cb = P.cb; LAS unsigned char* hl = P.hl;
    { const int wid = wr * 4 + wc, arr = wid >> 1, half = wid & 1, lane = fq * 16 + fr;
      const float* src = (arr < 3 ? cw + (size_t)arr * F2 : cb) + half * FF + 128 * u.pn;
      LAS unsigned* dst = (LAS unsigned*)(hl + 8192 + wid * 512);
      __builtin_amdgcn_global_load_lds((const unsigned*)(src + lane), dst, 4, 0, 0);
      __builtin_amdgcn_global_load_lds((const unsigned*)(src + 64 + lane), dst + 64, 4, 0, 0); }
}
struct AccViewF { const f32x4 (&a)[2][2][4][2]; __device__ __forceinline__ f32x4 operator()(int ai, int bj, int m, int n) const { return a[ai][bj][m][n]; } };
struct AccViewI { const i32x4 (&a)[2][2][4][2]; __device__ __forceinline__ f32x4 operator()(int ai, int bj, int m, int n) const { return __builtin_bit_cast(f32x4, a[ai][bj][m][n]); } };
template <class View>
__device__ __forceinline__ void conv_act_body(const View& A, const ConvActArgs& P, const pg8::Unit& u, int wr, int wc, int fr, int fq) {
    bf16* ACT = P.ACT; float* HALO = P.HALO; float* HEAD = P.HEAD; LAS unsigned char* hl = P.hl;
    {
        const int cbase = wc * 32 + 8 * fq;
#pragma unroll
        for (int ai = 0; ai < 2; ++ai)
#pragma unroll
            for (int bj = 0; bj < 2; ++bj)
#pragma unroll
                for (int n = 0; n < 2; ++n) if (fr >= 14) *(LAS f32x4*)(hl + ((((ai * 2 + wr) * 2 + (fr - 14)) * 256 + 128 * bj + cbase + 4 * n) * 4)) = A(ai, bj, 3, n);
        if (wr == 1 && fr >= 14) {
#pragma unroll
            for (int bj = 0; bj < 2; ++bj)
#pragma unroll
                for (int n = 0; n < 2; ++n) *(f32x4*)(HALO + (size_t)(u.pm * 2 + fr - 14) * F2 + 256 * u.pn + 128 * bj + cbase + 4 * n) = A(1, bj, 3, n);
        }
        if (wr == 0 && fr < 2) {
#pragma unroll
            for (int bj = 0; bj < 2; ++bj)
#pragma unroll
                for (int n = 0; n < 2; ++n) *(f32x4*)(HEAD + (size_t)(u.pm * 2 + fr) * F2 + 256 * u.pn + 128 * bj + cbase + 4 * n) = A(0, bj, 0, n);
        }
        asm volatile("s_waitcnt vmcnt(4) lgkmcnt(0)" ::: "memory"); __builtin_amdgcn_s_barrier(); asm volatile("" ::: "memory");
        const int row0 = u.pm * 256 + wr * 64 + fr;
#pragma unroll
        for (int n = 0; n < 2; ++n) {
            const LAS unsigned char* wl = hl + 8192 + (cbase + 4 * n) * 4;
#pragma unroll
            for (int ai = 0; ai < 2; ++ai)
#pragma unroll
                for (int m = 0; m < 4; ++m) {
                    const f32x4 cg = A(ai, 0, m, n), cu = A(ai, 1, m, n);
                    f32x4 pg1, pg2, pu1, pu2;
                    if (m == 0) {
                        f32x4 g14 = {0.f, 0.f, 0.f, 0.f}, g15 = g14, u14 = g14, u15 = g14;
                        if (wr == 1 || ai == 1) { const int grp = (wr == 1) ? ai * 2 : 1; const LAS unsigned char* hb = hl + ((grp * 2) * 256 + cbase + 4 * n) * 4;
                            g14 = *(const LAS f32x4*)hb; g15 = *(const LAS f32x4*)(hb + 1024); u14 = *(const LAS f32x4*)(hb + 512); u15 = *(const LAS f32x4*)(hb + 1536); }
#pragma unroll
                        for (int j = 0; j < 4; ++j) {
                            pg1[j] = dppf_old<0x111>(g15[j], cg[j]); pg2[j] = dppf_old<0x112>(fr == 0 ? g14[j] : g15[j], cg[j]);
                            pu1[j] = dppf_old<0x111>(u15[j], cu[j]); pu2[j] = dppf_old<0x112>(fr == 0 ? u14[j] : u15[j], cu[j]); }
                    } else {
                        const f32x4 qg = A(ai, 0, m > 0 ? m - 1 : 0, n), qu = A(ai, 1, m > 0 ? m - 1 : 0, n);
#pragma unroll
                        for (int j = 0; j < 4; ++j) {
                            pg1[j] = dppf_old<0x111>(dppf<0x121>(qg[j]), cg[j]); pg2[j] = dppf_old<0x112>(dppf<0x122>(qg[j]), cg[j]);
                            pu1[j] = dppf_old<0x111>(dppf<0x121>(qu[j]), cu[j]); pu2[j] = dppf_old<0x112>(dppf<0x122>(qu[j]), cu[j]); }
                    }
                    const f32x4 wg0 = *(const LAS f32x4*)(wl), wg1 = *(const LAS f32x4*)(wl + 1024), wg2 = *(const LAS f32x4*)(wl + 2048), bg = *(const LAS f32x4*)(wl + 3072);
                    const f32x4 gv = bg + wg0 * pg2 + wg1 * pg1 + wg2 * cg;
                    const f32x4 wu0 = *(const LAS f32x4*)(wl + 512), wu1 = *(const LAS f32x4*)(wl + 1536), wu2 = *(const LAS f32x4*)(wl + 2560), bu = *(const LAS f32x4*)(wl + 3584);
                    const f32x4 uv = bu + wu0 * pu2 + wu1 * pu1 + wu2 * cu;
                    v2u pk; pk.x = pg8::cvt_pk_bf16(silu_mul(gv[0], uv[0]), silu_mul(gv[1], uv[1])); pk.y = pg8::cvt_pk_bf16(silu_mul(gv[2], uv[2]), silu_mul(gv[3], uv[3]));
                    *(v2u*)(ACT + (size_t)(row0 + ai * 128 + m * 16) * FF + 128 * u.pn + cbase + 4 * n) = pk;
                }
        }
    }
}
struct EpiConvAct {
    static constexpr bool PERM = true, AFTER_DRAIN = false;
    ConvActArgs P; const float* SS;
    __device__ __forceinline__ void operator()(const f32x4 (&acc)[2][2][4][2], const pg8::Unit& u, int wr, int wc, int fr, int fq) const {
        conv_taps_dma(P, u, wr, wc, fr, fq);
        scale_rows_by_rstd(const_cast<f32x4 (&)[2][2][4][2]>(acc), SS, u.pm * 256 + wr * 64 + fr, fq);
        conv_act_body(AccViewF{acc}, P, u, wr, wc, fr, fq);
    }
};
__device__ __forceinline__ void phase_conv_fixup(const Ctx& C0, int layer) {
    Ctx C = C0; C.lane = fresh_lane(); C.tid = C.wave * 64 + C.lane;
    const float* cw = C.ffn_conv_w + (size_t)layer * 3 * F2; const float* cb = C.ffn_conv_b + (size_t)layer * F2;
    constexpr int NQ = FF / 4;
    for (int idx = C.bid * NTHR + C.tid; idx < 64 * NQ; idx += C.G * NTHR) {
        const int pm = idx / NQ, c = (idx % NQ) * 4;
        if ((pm & 31) == 0) continue;
        const int pc = (c >> 7) * 256 + (c & 127);
        const f32x4 wg0 = *(const f32x4*)(cw + c), wg1 = *(const f32x4*)(cw + F2 + c), wg2 = *(const f32x4*)(cw + 2 * F2 + c), bg = *(const f32x4*)(cb + c);
        const f32x4 wu0 = *(const f32x4*)(cw + FF + c), wu1 = *(const f32x4*)(cw + F2 + FF + c), wu2 = *(const f32x4*)(cw + 2 * F2 + FF + c), bu = *(const f32x4*)(cb + FF + c);
        const f32x4 gm2 = *(const f32x4*)(C.HALO + (size_t)((pm - 1) * 2) * F2 + pc), gm1 = *(const f32x4*)(C.HALO + (size_t)((pm - 1) * 2 + 1) * F2 + pc);
        const f32x4 g0 = *(const f32x4*)(C.HEAD + (size_t)(pm * 2) * F2 + pc), g1 = *(const f32x4*)(C.HEAD + (size_t)(pm * 2 + 1) * F2 + pc);
        const f32x4 um2 = *(const f32x4*)(C.HALO + (size_t)((pm - 1) * 2) * F2 + pc + 128), um1 = *(const f32x4*)(C.HALO + (size_t)((pm - 1) * 2 + 1) * F2 + pc + 128);
        const f32x4 u0 = *(const f32x4*)(C.HEAD + (size_t)(pm * 2) * F2 + pc + 128), u1 = *(const f32x4*)(C.HEAD + (size_t)(pm * 2 + 1) * F2 + pc + 128);
        const f32x4 ga = bg + wg0 * gm2 + wg1 * gm1 + wg2 * g0, ua = bu + wu0 * um2 + wu1 * um1 + wu2 * u0;
        const f32x4 gb = bg + wg0 * gm1 + wg1 * g0 + wg2 * g1, ub = bu + wu0 * um1 + wu1 * u0 + wu2 * u1;
        v2u a, b2;
        a.x = pg8::cvt_pk_bf16(silu_mul(ga[0], ua[0]), silu_mul(ga[1], ua[1])); a.y = pg8::cvt_pk_bf16(silu_mul(ga[2], ua[2]), silu_mul(ga[3], ua[3]));
        b2.x = pg8::cvt_pk_bf16(silu_mul(gb[0], ub[0]), silu_mul(gb[1], ub[1])); b2.y = pg8::cvt_pk_bf16(silu_mul(gb[2], ub[2]), silu_mul(gb[3], ub[3]));
        *(v2u*)(C.ACT + (size_t)(pm * 256) * FF + c) = a; *(v2u*)(C.ACT + (size_t)(pm * 256 + 1) * FF + c) = b2;
    }
}
__device__ __forceinline__ f32x4 cvt_i32x4(i32x4 v) { return (f32x4){(float)v[0], (float)v[1], (float)v[2], (float)v[3]}; }
struct EpiResidBfI8 {
    static constexpr bool PERM = true, AFTER_DRAIN = false;
    const float* base32; const bf16* base16; bf16* out; float* SS; LAS unsigned char* hl; const float* SA; const unsigned* wmax;
    __device__ __forceinline__ void operator()(const i32x4 (&acc)[2][2][4][2], const pg8::Unit& u, int wr, int wc, int fr, int fq) const {
        const int row0 = u.pm * 256 + wr * 64 + fr, col0 = u.pn * 256 + wc * 32 + 8 * fq;
        v4u wraw[2][2]; float sa[2][4];
#pragma unroll
        for (int bj = 0; bj < 2; ++bj)
#pragma unroll
            for (int n = 0; n < 2; ++n) wraw[bj][n] = *(const v4u*)(wmax + col0 + bj * 128 + 4 * n);
#pragma unroll
        for (int ai = 0; ai < 2; ++ai)
#pragma unroll
            for (int m = 0; m < 4; ++m) sa[ai][m] = SA[row0 + ai * 128 + m * 16];
        v4u rb[4][2][2][2];
        auto LQ = [&](const int q) { const int ai = q >> 1, mh = q & 1;
#pragma unroll
            for (int mm = 0; mm < 2; ++mm)
#pragma unroll
                for (int bj = 0; bj < 2; ++bj) { const size_t off = (size_t)(row0 + ai * 128 + (2 * mh + mm) * 16) * DM + col0 + bj * 128;
                    if (base32) { rb[q][mm][bj][0] = *(const v4u*)(base32 + off); rb[q][mm][bj][1] = *(const v4u*)(base32 + off + 4); }
                    else rb[q][mm][bj][0] = *(const v4u*)(base16 + off); } };
        f32x4 sb[2][2];
        auto CQ = [&](const int q) { const int ai = q >> 1, mh = q & 1;
#pragma unroll
            for (int mm = 0; mm < 2; ++mm) { const int m = 2 * mh + mm; const size_t off = (size_t)(row0 + ai * 128 + m * 16) * DM + col0;
#pragma unroll
                for (int bj = 0; bj < 2; ++bj) { f32x4 b0, b1;
                    if (base32) { b0 = __builtin_bit_cast(f32x4, rb[q][mm][bj][0]); b1 = __builtin_bit_cast(f32x4, rb[q][mm][bj][1]); }
                    else { const v4u x = rb[q][mm][bj][0]; b0 = (f32x4){bflo(x.x), bfhi(x.x), bflo(x.y), bfhi(x.y)}; b1 = (f32x4){bflo(x.z), bfhi(x.z), bflo(x.w), bfhi(x.w)}; }
                    const f32x4 v0 = b0 + cvt_i32x4(acc[ai][bj][m][0]) * (sb[bj][0] * sa[ai][m]), v1 = b1 + cvt_i32x4(acc[ai][bj][m][1]) * (sb[bj][1] * sa[ai][m]);
                    v4u w; w.x = pg8::cvt_pk_bf16(v0[0], v0[1]); w.y = pg8::cvt_pk_bf16(v0[2], v0[3]); w.z = pg8::cvt_pk_bf16(v1[0], v1[1]); w.w = pg8::cvt_pk_bf16(v1[2], v1[3]);
                    *(v4u*)(out + off + bj * 128) = w; } } };
        LQ(0);
#pragma unroll
        for (int bj = 0; bj < 2; ++bj)
#pragma unroll
            for (int n = 0; n < 2; ++n) { const v4u w = wraw[bj][n]; sb[bj][n] = (f32x4){__uint_as_float(w.x), __uint_as_float(w.y), __uint_as_float(w.z), __uint_as_float(w.w)} * (1.0f / 127.0f); }
        if (base32) { CQ(0); LQ(1); CQ(1); LQ(2); CQ(2); LQ(3); CQ(3); }
        else { LQ(1); CQ(0); LQ(2); CQ(1); LQ(3); CQ(2); CQ(3); }
    }
};
struct EpiStoreBf16I8 {
    static constexpr bool PERM = true, AFTER_DRAIN = false;
    bf16* O; int ldc; const float* SS; float* KMH; const float* SA; const unsigned* wmax; bool HM;
    __device__ __forceinline__ void operator()(const i32x4 (&acc)[2][2][4][2], const pg8::Unit& u, int wr, int wc, int fr, int fq) const {
        const int row0 = u.pm * 256 + wr * 64 + fr, col0 = u.pn * 256 + wc * 32 + 8 * fq;
        float rsc[2][4];
        { f32x4 s0[2][4];
#pragma unroll
          for (int ai = 0; ai < 2; ++ai)
#pragma unroll
              for (int m = 0; m < 4; ++m) { const int row = row0 + ai * 128 + m * 16; rsc[ai][m] = SA[row]; s0[ai][m] = SS ? *(const f32x4*)(SS + (size_t)row * 16 + fq * 4) : (f32x4){0.f, 0.f, 0.f, 0.f}; }
          if (SS) {
#pragma unroll
              for (int ai = 0; ai < 2; ++ai)
#pragma unroll
                  for (int m = 0; m < 4; ++m) { float t = (s0[ai][m].x + s0[ai][m].y) + (s0[ai][m].z + s0[ai][m].w); t += __shfl_xor(t, 16); t += __shfl_xor(t, 32);
                      rsc[ai][m] = rsc[ai][m] / sqrtf(t * (1.0f / DM) + EPS); } } }
        f32x4 sb[2][2];
#pragma unroll
        for (int bj = 0; bj < 2; ++bj)
#pragma unroll
            for (int n = 0; n < 2; ++n) { const v4u w = *(const v4u*)(wmax + col0 + bj * 128 + 4 * n); sb[bj][n] = (f32x4){__uint_as_float(w.x), __uint_as_float(w.y), __uint_as_float(w.z), __uint_as_float(w.w)} * (1.0f / 127.0f); }
        if (KMH && u.pn >= 16 && u.pn < 32) {
#pragma unroll
            for (int bj = 0; bj < 2; ++bj)
#pragma unroll
                for (int n = 0; n < 2; ++n) { f32x4 cs = {0.f, 0.f, 0.f, 0.f};
#pragma unroll
                    for (int ai = 0; ai < 2; ++ai)
#pragma unroll
                        for (int m = 0; m < 4; ++m) cs = cs + cvt_i32x4(acc[ai][bj][m][n]) * rsc[ai][m];
                    cs = cs * sb[bj][n];
#pragma unroll
                    for (int j = 0; j < 4; ++j) { float v = cs[j]; v += __shfl_xor(v, 1); v += __shfl_xor(v, 2); v += __shfl_xor(v, 4); v += __shfl_xor(v, 8); cs[j] = v; }
                    if (fr == 0) { const int c = 256 * (u.pn - 16) + 128 * bj + 32 * wc + 8 * fq + 4 * n, hh = c >> 7, d = c & 127, bb = u.pm >> 5, nb = u.pm & 31;
                        *(f32x4*)(KMH + (size_t)wr * (64 * 32 * 128) + ((size_t)((bb * 32 + hh) * 32 + nb)) * 128 + d) = cs; } }
        }
#pragma unroll
        for (int ai = 0; ai < 2; ++ai)
#pragma unroll
            for (int m = 0; m < 4; ++m) { const int tok = row0 + ai * 128 + m * 16; bf16* rowp = O + (size_t)tok * ldc + col0;
#pragma unroll
                for (int bj = 0; bj < 2; ++bj) { const f32x4 v0 = cvt_i32x4(acc[ai][bj][m][0]) * (sb[bj][0] * rsc[ai][m]), v1 = cvt_i32x4(acc[ai][bj][m][1]) * (sb[bj][1] * rsc[ai][m]);
                    v4u w; w.x = pg8::cvt_pk_bf16(v0[0], v0[1]); w.y = pg8::cvt_pk_bf16(v0[2], v0[3]); w.z = pg8::cvt_pk_bf16(v1[0], v1[1]); w.w = pg8::cvt_pk_bf16(v1[2], v1[3]);
                    bf16* dst = HM ? O + hm_off(u.pn >> 4, tok >> 13, (u.pn & 15) * 2 + bj, tok & (SEQ - 1)) + wc * 32 + 8 * fq : rowp + bj * 128;
                    *(v4u*)dst = w; } }
    }
};
struct EpiConvActI8 {
    static constexpr bool PERM = true, AFTER_DRAIN = false;
    ConvActArgs P; const float* SS; const float* SA; const unsigned* wmax;
    __device__ __forceinline__ void operator()(const i32x4 (&acc)[2][2][4][2], const pg8::Unit& u, int wr, int wc, int fr, int fq) const {
        conv_taps_dma(P, u, wr, wc, fr, fq);
        __builtin_amdgcn_sched_barrier(0);
        const int row0 = u.pm * 256 + wr * 64 + fr, col0 = u.pn * 256 + wc * 32 + 8 * fq;
        float rsc[2][4];
#pragma unroll
        for (int ai = 0; ai < 2; ++ai)
#pragma unroll
            for (int m = 0; m < 4; ++m) rsc[ai][m] = SA[row0 + ai * 128 + m * 16];
        i32x4 (&ia)[2][2][4][2] = const_cast<i32x4 (&)[2][2][4][2]>(acc);
        v4u wraw[2][2];
#pragma unroll
        for (int bj = 0; bj < 2; ++bj)
#pragma unroll
            for (int n = 0; n < 2; ++n) wraw[bj][n] = *(const v4u*)(wmax + col0 + bj * 128 + 4 * n);
        __builtin_amdgcn_sched_barrier(0);
#pragma unroll
        for (int bj = 0; bj < 2; ++bj)
#pragma unroll
            for (int n = 0; n < 2; ++n) { const v4u w = wraw[bj][n];
                const f32x4 sb = (f32x4){__uint_as_float(w.x), __uint_as_float(w.y), __uint_as_float(w.z), __uint_as_float(w.w)} * (1.0f / 127.0f);
#pragma unroll
                for (int ai = 0; ai < 2; ++ai)
#pragma unroll
                    for (int m = 0; m < 4; ++m) ia[ai][bj][m][n] = __builtin_bit_cast(i32x4, cvt_i32x4(ia[ai][bj][m][n]) * (sb * rsc[ai][m])); }
        conv_act_body(AccViewI{acc}, P, u, wr, wc, fr, fq);
    }
};
template <class Epi>
__device__ __forceinline__ void run_gemm_i8(const Ctx& C, const signed char* A8, const signed char* B8, int N, int K, const Epi& E) {
    pg8::Gemm g{(const bf16*)A8, (const bf16*)B8, MTOK, N, K / 2}; pg8::StaticOrder S; S.init(MTOK, N, C.G, C.bid);
    pg8::gemm_phase_i8<Epi, pg8::StaticOrder, true, true>(C.lds, g, S, E);
}
template <class Epi>
__device__ __forceinline__ void run_gemm(const Ctx& C, const bf16* A, const bf16* Bt, int N, int K, const Epi& E) {
    pg8::Gemm g{A, Bt, MTOK, N, K}; pg8::StaticOrder S; S.init(MTOK, N, C.G, C.bid);
    pg8::gemm_phase<Epi, pg8::StaticOrder, true, true>(C.lds, g, S, E);
}

__device__ __forceinline__ void phase_gates(const Ctx& C0) {
    Ctx C = C0; C.lane = fresh_lane(); C.tid = C.wave * 64 + C.lane;
    const int gw = C.bid * NWAVES + C.wave, NGW = C.G * NWAVES, l = C.lane, g = l >> 4;
    for (int task = gw; task < (MTOK / 16) * 4; task += NGW) {
        const int tile = task >> 2, kp = task & 3;
        const bf16* ar = C.XN + (size_t)(tile * 16 + (l & 15)) * DM + kp * 1024 + g * 8;
        const bf16* br = C.Wg + (size_t)(l & 15) * DM + kp * 1024 + g * 8;
        f32x4 acc = {0.f, 0.f, 0.f, 0.f};
#pragma unroll 16
        for (int s = 0; s < 32; ++s) acc = mfma16(*(const bf16x8*)(ar + 32 * s), *(const bf16x8*)(br + 32 * s), acc);
#pragma unroll
        for (int r = 0; r < 4; ++r) C.GATES[((size_t)kp * MTOK + tile * 16 + 4 * g + r) * 16 + (l & 15)] = acc[r];
    }
}
__device__ __forceinline__ float softcap15(float v) { return 15.0f * tanhf(v * (1.0f / 15.0f)); }
__device__ __forceinline__ float logsig(float v) { return fminf(v, 0.f) - log1pf(expf(-fabsf(v))); }
__device__ __forceinline__ void phase_gate_scan(const Ctx& C0) {
    Ctx C = C0; C.lane = fresh_lane(); C.tid = C.wave * 64 + C.lane;
    if (C.bid >= 16) return;
    const int bh = C.bid, b = bh >> 3, h = bh & 7, tid = C.tid, lane = C.lane, wave = C.wave;
    LAS float* red = (LAS float*)C.lds;
    const float bi = C.a_gate_bias[h], bf_ = C.a_gate_bias[8 + h];
    float a[16], lf[16];
    float c = 0.f;
#pragma unroll
    for (int q = 0; q < 16; ++q) { a[q] = bi; lf[q] = bf_; }
#pragma unroll
    for (int kp = 0; kp < 4; ++kp)
#pragma unroll
        for (int q = 0; q < 16; ++q) { const size_t row = (size_t)b * SEQ + tid * 16 + q; a[q] += C.GATES[((size_t)kp * MTOK + row) * 16 + h]; lf[q] += C.GATES[((size_t)kp * MTOK + row) * 16 + 8 + h]; }
#pragma unroll
    for (int q = 0; q < 16; ++q) { a[q] = softcap15(a[q]); c += logsig(softcap15(lf[q])); lf[q] = c; }
    float inc = c;
#pragma unroll
    for (int o = 1; o < 64; o <<= 1) { const float t = __shfl_up(inc, o); if (lane >= o) inc += t; }
    if (lane == 63) red[wave] = inc;
    __syncthreads();
    float base = 0.f;
    for (int w = 0; w < wave; ++w) base += red[w];
    const float ex = base + inc - c;
    float mloc = -INFINITY;
#pragma unroll
    for (int q = 0; q < 16; ++q) { const float F = ex + lf[q]; const size_t o = (size_t)bh * SEQ + tid * 16 + q; C.FFv[o] = F; a[q] = a[q] - F; C.FA[o] = a[q]; mloc = fmaxf(mloc, a[q]); lf[q] = mloc; }
    float minc = mloc;
#pragma unroll
    for (int o = 1; o < 64; o <<= 1) { const float t = __shfl_up(minc, o); if (lane >= o) minc = fmaxf(minc, t); }
    __syncthreads();
    if (lane == 63) red[16 + wave] = minc;
    __syncthreads();
    float pm = 0.f;
    for (int w = 0; w < wave; ++w) pm = fmaxf(pm, red[16 + w]);
    { const float t = __shfl_up(minc, 1); if (lane >= 1) pm = fmaxf(pm, t); }
#pragma unroll
    for (int q = 0; q < 16; ++q) C.FG[(size_t)bh * SEQ + tid * 16 + q] = fmaxf(pm, lf[q]);
}
__device__ __forceinline__ void phase_mlstm_u(const Ctx& C0) {
    Ctx C = C0; C.lane = fresh_lane(); C.tid = C.wave * 64 + C.lane;
    LAS bf16* KT = (LAS bf16*)C.lds;
    LAS bf16* VT = (LAS bf16*)(C.lds + 69632);
    const int tid = C.tid, l = C.lane, g = l >> 4, w = C.wave;
    for (int u = C.bid; u < 1024; u += C.G) {
        const int bh = u >> 6, c = u & 63, b = bh >> 3, h = bh & 7, tokbase = b * SEQ + c * 128;
        const float Rc = C.FG[(size_t)bh * SEQ + c * 128 + 127];
        __syncthreads();
        const int i = tid & 127, cg = tid >> 7;
        const float wi = expf(C.FA[(size_t)bh * SEQ + c * 128 + i] - Rc) * 0.0625f;
        const bf16* krow = C.PROJ + (size_t)(tokbase + i) * NPROJ + 2048 + h * 256;
        { v4u kx[8];
#pragma unroll
          for (int k = 0; k < 8; ++k) kx[k] = *(const v4u*)(krow + (cg + 4 * k) * 8);
#pragma unroll
          for (int k = 0; k < 8; ++k) { const v4u x = kx[k]; LAS bf16* dst = KT + ((cg + 4 * k) * 8) * 136 + i;
            const unsigned p0 = pg8::cvt_pk_bf16(bflo(x.x) * wi, bfhi(x.x) * wi), p1 = pg8::cvt_pk_bf16(bflo(x.y) * wi, bfhi(x.y) * wi), p2 = pg8::cvt_pk_bf16(bflo(x.z) * wi, bfhi(x.z) * wi), p3 = pg8::cvt_pk_bf16(bflo(x.w) * wi, bfhi(x.w) * wi);
            dst[0 * 136] = (bf16)(p0 & 0xffffu); dst[1 * 136] = (bf16)(p0 >> 16); dst[2 * 136] = (bf16)(p1 & 0xffffu); dst[3 * 136] = (bf16)(p1 >> 16);
            dst[4 * 136] = (bf16)(p2 & 0xffffu); dst[5 * 136] = (bf16)(p2 >> 16); dst[6 * 136] = (bf16)(p3 & 0xffffu); dst[7 * 136] = (bf16)(p3 >> 16); } }
        bf16x8 af[2][4];
#pragma unroll 1
        for (int ec = 0; ec < 3; ++ec) {
            if (ec > 0) __syncthreads();
            const bf16* vrow = C.PROJ + (size_t)(tokbase + i) * NPROJ + 4096 + h * 512 + ec * 176;
            v4u vxx[6];
#pragma unroll
            for (int k = 0; k < 6; ++k) { const int ch = cg + 4 * k; vxx[k] = (ch < 22 && ec * 176 + ch * 8 < 512) ? *(const v4u*)(vrow + ch * 8) : (v4u){0u, 0u, 0u, 0u}; }
#pragma unroll
            for (int k = 0; k < 6; ++k) { const int ch = cg + 4 * k; if (ch >= 22) continue; const int e0 = ec * 176 + ch * 8; LAS bf16* dst = VT + (ch * 8) * 136 + i;
                if (e0 < 512) { const v4u x = vxx[k];
                    dst[0 * 136] = (bf16)(x.x & 0xffffu); dst[1 * 136] = (bf16)(x.x >> 16); dst[2 * 136] = (bf16)(x.y & 0xffffu); dst[3 * 136] = (bf16)(x.y >> 16);
                    dst[4 * 136] = (bf16)(x.z & 0xffffu); dst[5 * 136] = (bf16)(x.z >> 16); dst[6 * 136] = (bf16)(x.w & 0xffffu); dst[7 * 136] = (bf16)(x.w >> 16);
                } else {
#pragma unroll
                    for (int jj = 0; jj < 8; ++jj) dst[jj * 136] = (bf16)((e0 + jj == 512) ? 0x3F80u : 0u); } }
            __syncthreads();
            if (ec == 0) {
#pragma unroll
                for (int mt = 0; mt < 2; ++mt)
#pragma unroll
                    for (int s = 0; s < 4; ++s) af[mt][s] = *(const LAS bf16x8*)(KT + (16 * (2 * w + mt) + (l & 15)) * 136 + s * 32 + g * 8);
            }
#pragma unroll 1
            for (int et = 0; et < 11; ++et) {
                bf16x8 bfr[4];
#pragma unroll
                for (int s = 0; s < 4; ++s) bfr[s] = *(const LAS bf16x8*)(VT + (16 * et + (l & 15)) * 136 + s * 32 + g * 8);
                const int e = ec * 176 + 16 * et + (l & 15);
#pragma unroll
                for (int mt = 0; mt < 2; ++mt) { f32x4 acc = {0.f, 0.f, 0.f, 0.f};
#pragma unroll
                    for (int s = 0; s < 4; ++s) acc = mfma16(af[mt][s], bfr[s], acc);
                    v2u o; o.x = pk2(acc[0], acc[1]); o.y = pk2(acc[2], acc[3]);
                    *(v2u*)(C.UT + ((size_t)u * 528 + e) * 256 + 16 * (2 * w + mt) + 4 * g) = o; }
            }
        }
    }
}
__device__ __forceinline__ void phase_mlstm_scan(const Ctx& C0) {
    Ctx C = C0; C.lane = fresh_lane(); C.tid = C.wave * 64 + C.lane;
    constexpr int GRP = 528 * 256 / 8;
    for (int gi = C.bid * NTHR + C.tid; gi < 16 * GRP; gi += C.G * NTHR) {
        const int bh = gi / GRP; const size_t off = (size_t)(gi % GRP) * 8;
        float s[8];
#pragma unroll
        for (int j = 0; j < 8; ++j) s[j] = 0.f;
        float Rprev = 0.f;
#pragma unroll 1
        for (int c0 = 0; c0 < 63; c0 += 8) {
            v4u ux[8]; float rc[8];
#pragma unroll
            for (int k = 0; k < 8; ++k) { const int c = (c0 + k < 63) ? c0 + k : 62; ux[k] = *(const v4u*)(C.UT + (size_t)(bh * 64 + c) * (528 * 256) + off); rc[k] = C.FG[(size_t)bh * SEQ + c * 128 + 127]; }
#pragma unroll
            for (int k = 0; k < 8; ++k) {
                if (c0 + k < 63) {
                    const v4u x = ux[k]; const float a = __builtin_amdgcn_exp2f((Rprev - rc[k]) * 1.4426950408889634f); Rprev = rc[k];
                    s[0] = a * s[0] + bflo(x.x); s[1] = a * s[1] + bfhi(x.x); s[2] = a * s[2] + bflo(x.y); s[3] = a * s[3] + bfhi(x.y);
                    s[4] = a * s[4] + bflo(x.z); s[5] = a * s[5] + bfhi(x.z); s[6] = a * s[6] + bflo(x.w); s[7] = a * s[7] + bfhi(x.w);
                    v4u o; o.x = pg8::cvt_pk_bf16(s[0], s[1]); o.y = pg8::cvt_pk_bf16(s[2], s[3]); o.z = pg8::cvt_pk_bf16(s[4], s[5]); o.w = pg8::cvt_pk_bf16(s[6], s[7]);
                    *(v4u*)(C.ST + (size_t)(bh * 64 + c0 + k + 1) * (528 * 256) + off) = o;
                }
            }
        }
    }
}
__device__ __forceinline__ void phase_mlstm_out(const Ctx& C0) {
    Ctx C = C0; C.lane = fresh_lane(); C.tid = C.wave * 64 + C.lane;
    LAS unsigned char* X = C.lds;
    LAS unsigned char* Y = C.lds + 110592;
    const int tid = C.tid, l = C.lane, g = l >> 4, w = C.wave;
    LAS bf16* Pw = (LAS bf16*)(C.lds + 75776 + w * 4352);
    LAS float* fa = (LAS float*)(C.lds + 145408); LAS float* fg = fa + 128; LAS float* ff = fa + 256; LAS float* fa_rs = fa + 384;
    for (int u = C.bid; u < 1024; u += C.G) {
        const int bh = u >> 6, c = u & 63, b = bh >> 3, h = bh & 7, tokbase = b * SEQ + c * 128;
        const float Rprev = (c == 0) ? 0.f : C.FG[(size_t)bh * SEQ + c * 128 - 1];
        __syncthreads();
        { v4u kt8[8];
#pragma unroll
          for (int it = 0; it < 8; ++it) { const int q = tid + 512 * it, key = q >> 5, ch = q & 31; kt8[it] = *(const v4u*)(C.PROJ + (size_t)(tokbase + key) * NPROJ + 2048 + h * 256 + ch * 8); }
#pragma unroll
          for (int it = 0; it < 8; ++it) { const int q = tid + 512 * it, key = q >> 5, ch = q & 31; *(LAS v4u*)(X + key * 528 + ch * 16) = kt8[it]; } }
        if (tid < 128) { const size_t o = (size_t)bh * SEQ + c * 128 + tid; fa[tid] = C.FA[o]; fg[tid] = C.FG[o]; ff[tid] = C.FFv[o]; }
        bf16x8 qf[8];
        { const bf16* qrow = C.PROJ + (size_t)(tokbase + 16 * w + (l & 15)) * NPROJ + h * 256 + g * 8;
#pragma unroll
          for (int s = 0; s < 8; ++s) qf[s] = *(const bf16x8*)(qrow + 32 * s); }
        __syncthreads();
#pragma unroll
        for (int kt = 0; kt < 8; ++kt) {
            f32x4 sa = {0.f, 0.f, 0.f, 0.f};
#pragma unroll
            for (int s = 0; s < 8; ++s) sa = mfma16(qf[s], *(const LAS bf16x8*)(X + (16 * kt + (l & 15)) * 528 + s * 64 + g * 16), sa);
            const int ikey = 16 * kt + (l & 15);
#pragma unroll
            for (int r = 0; r < 4; ++r) { const int jrow = 16 * w + 4 * g + r;
                const float val = (ikey <= jrow) ? sa[r] * __builtin_amdgcn_exp2f(fminf(fa[ikey] - fg[jrow], 0.f) * 1.4426950408889634f) * 0.0625f : 0.f;
                Pw[(4 * g + r) * 136 + ikey] = (bf16)(pg8::cvt_pk_bf16(val, val) & 0xffffu); }
            __builtin_amdgcn_sched_barrier(0);
        }
        LDS_WAIT();
        bf16x8 pf[4];
#pragma unroll
        for (int ks = 0; ks < 4; ++ks) pf[ks] = *(const LAS bf16x8*)(Pw + (l & 15) * 136 + ks * 32 + g * 8);
        float sc[4], inv[4], ss[4] = {0.f, 0.f, 0.f, 0.f};
#pragma unroll
        for (int r = 0; r < 4; ++r) sc[r] = expf(fminf(Rprev - fg[16 * w + 4 * g + r], 0.f));
        bf16* const hbase = C.HG + (size_t)(tokbase + 16 * w) * DM + h * 512;
        const bf16* const obase = C.PROJ + (size_t)(tokbase + 16 * w) * NPROJ + 8192 + h * 512;
        {
            __syncthreads();
            if (c > 0) { const int r = tid >> 5, ch = tid & 31; *(LAS v4u*)(X + r * 528 + ch * 16) = *(const v4u*)(C.ST + ((size_t)u * 528 + 512 + r) * 256 + ch * 8); }
            { LAS bf16* yt = (LAS bf16*)Y; for (int q = tid; q < 16 * 128; q += 512) yt[(q >> 7) * 136 + (q & 127)] = (bf16)(((q >> 7) == 0) ? 0x3F80u : 0u); }
            __syncthreads();
            f32x4 a = {0.f, 0.f, 0.f, 0.f};
            if (c > 0) {
#pragma unroll
                for (int s = 0; s < 8; ++s) a = mfma16(qf[s], *(const LAS bf16x8*)(X + (l & 15) * 528 + s * 64 + g * 16), a);
                a[0] *= sc[0]; a[1] *= sc[1]; a[2] *= sc[2]; a[3] *= sc[3];
            }
#pragma unroll
            for (int ks = 0; ks < 4; ++ks) a = mfma16(pf[ks], *(const LAS bf16x8*)(Y + (l & 15) * 272 + ks * 64 + g * 16), a);
#pragma unroll
            for (int r = 0; r < 4; ++r) { const int jrow = 16 * w + 4 * g + r; const float den = __shfl(a[r], l & 48);
                const float dn = fmaxf(fabsf(den), expf(-(ff[jrow] + fg[jrow]))); inv[r] = 1.0f / dn; }
        }
#pragma unroll 1
        for (int ec = 0; ec < 4; ++ec) {
            __syncthreads();
            v4u stg[8], vx[4];
            { const int i = tid & 127, cg = tid >> 7; const bf16* vrow = C.PROJ + (size_t)(tokbase + i) * NPROJ + 4096 + h * 512 + 128 * ec;
#pragma unroll
              for (int k = 0; k < 4; ++k) vx[k] = *(const v4u*)(vrow + (cg + 4 * k) * 8); }
            if (c > 0) {
#pragma unroll
                for (int it = 0; it < 8; ++it) { const int q = tid + 512 * it, r = q >> 5, ch = q & 31; stg[it] = *(const v4u*)(C.ST + ((size_t)u * 528 + 128 * ec + r) * 256 + ch * 8); }
#pragma unroll
                for (int it = 0; it < 8; ++it) { const int q = tid + 512 * it, r = q >> 5, ch = q & 31; *(LAS v4u*)(X + r * 528 + ch * 16) = stg[it]; }
            }
            { const int i = tid & 127, cg = tid >> 7; LAS bf16* yt = (LAS bf16*)Y;
#pragma unroll
              for (int k = 0; k < 4; ++k) { const int ch = cg + 4 * k; const v4u x = vx[k]; LAS bf16* dst = yt + (ch * 8) * 136 + i;
                  dst[0 * 136] = (bf16)(x.x & 0xffffu); dst[1 * 136] = (bf16)(x.x >> 16); dst[2 * 136] = (bf16)(x.y & 0xffffu); dst[3 * 136] = (bf16)(x.y >> 16);
                  dst[4 * 136] = (bf16)(x.z & 0xffffu); dst[5 * 136] = (bf16)(x.z >> 16); dst[6 * 136] = (bf16)(x.w & 0xffffu); dst[7 * 136] = (bf16)(x.w >> 16); } }
            __syncthreads();
            f32x4 acc[8];
#pragma unroll
            for (int t = 0; t < 8; ++t) acc[t] = (f32x4){0.f, 0.f, 0.f, 0.f};
            if (c > 0) {
#pragma unroll
                for (int et = 0; et < 8; ++et) {
#pragma unroll
                    for (int s = 0; s < 8; ++s) acc[et] = mfma16(qf[s], *(const LAS bf16x8*)(X + (16 * et + (l & 15)) * 528 + s * 64 + g * 16), acc[et]);
                    acc[et][0] *= sc[0]; acc[et][1] *= sc[1]; acc[et][2] *= sc[2]; acc[et][3] *= sc[3];
                    __builtin_amdgcn_sched_barrier(0);
                }
            }
#pragma unroll
            for (int et = 0; et < 8; ++et) {
#pragma unroll
                for (int ks = 0; ks < 4; ++ks) acc[et] = mfma16(pf[ks], *(const LAS bf16x8*)(Y + (16 * et + (l & 15)) * 272 + ks * 64 + g * 16), acc[et]);
#pragma unroll
                for (int r = 0; r < 4; ++r) { const float hv = acc[et][r] * inv[r]; ss[r] += hv * hv; Pw[(4 * g + r) * 136 + 16 * et + (l & 15)] = (bf16)(pg8::cvt_pk_bf16(hv, hv) & 0xffffu); }
                __builtin_amdgcn_sched_barrier(0);
            }
            LDS_WAIT();
#pragma unroll
            for (int i = 0; i < 4; ++i) { const int v = l + 64 * i, row = v >> 4, cv = v & 15;
                *(v4u*)(hbase + (size_t)row * DM + 128 * ec + cv * 8) = *(const LAS v4u*)((LAS unsigned char*)Pw + row * 272 + cv * 16); }
            LDS_WAIT();
        }
        {
#pragma unroll
            for (int r = 0; r < 4; ++r) { float t = ss[r]; t += __shfl_xor(t, 1); t += __shfl_xor(t, 2); t += __shfl_xor(t, 4); t += __shfl_xor(t, 8);
                const float rsv = 1.0f / sqrtf(t * (1.0f / 512.0f) + EPS); if ((l & 15) == 0) fa_rs[16 * w + 4 * g + r] = rsv; }
            LDS_WAIT(); VM_WAIT();
            const f32x4* hgp = (const f32x4*)(C.a_head_norm + h * 512) + 2 * l;
            const f32x4 hg0 = hgp[0], hg1 = hgp[1];
#pragma unroll 1
            for (int i4 = 0; i4 < 16; i4 += 4) {
                v4u hv4[4], ov4[4];
#pragma unroll
                for (int k = 0; k < 4; ++k) { hv4[k] = *(const v4u*)(hbase + (size_t)(i4 + k) * DM + 8 * l); ov4[k] = *(const v4u*)(obase + (size_t)(i4 + k) * NPROJ + 8 * l); }
#pragma unroll
                for (int k = 0; k < 4; ++k) {
                    const float rsv = fa_rs[16 * w + i4 + k]; const v4u hv = hv4[k], ov = ov4[k];
                    float o[8];
                    o[0] = bflo(hv.x) * hg0.x * __builtin_amdgcn_rcpf(1.0f + __builtin_amdgcn_exp2f(-1.4426950408889634f * bflo(ov.x)));
                    o[1] = bfhi(hv.x) * hg0.y * __builtin_amdgcn_rcpf(1.0f + __builtin_amdgcn_exp2f(-1.4426950408889634f * bfhi(ov.x)));
                    o[2] = bflo(hv.y) * hg0.z * __builtin_amdgcn_rcpf(1.0f + __builtin_amdgcn_exp2f(-1.4426950408889634f * bflo(ov.y)));
                    o[3] = bfhi(hv.y) * hg0.w * __builtin_amdgcn_rcpf(1.0f + __builtin_amdgcn_exp2f(-1.4426950408889634f * bfhi(ov.y)));
                    o[4] = bflo(hv.z) * hg1.x * __builtin_amdgcn_rcpf(1.0f + __builtin_amdgcn_exp2f(-1.4426950408889634f * bflo(ov.z)));
                    o[5] = bfhi(hv.z) * hg1.y * __builtin_amdgcn_rcpf(1.0f + __builtin_amdgcn_exp2f(-1.4426950408889634f * bfhi(ov.z)));
                    o[6] = bflo(hv.w) * hg1.z * __builtin_amdgcn_rcpf(1.0f + __builtin_amdgcn_exp2f(-1.4426950408889634f * bflo(ov.w)));
                    o[7] = bfhi(hv.w) * hg1.w * __builtin_amdgcn_rcpf(1.0f + __builtin_amdgcn_exp2f(-1.4426950408889634f * bfhi(ov.w)));
                    v4u wv; wv.x = pg8::cvt_pk_bf16(o[0] * rsv, o[1] * rsv); wv.y = pg8::cvt_pk_bf16(o[2] * rsv, o[3] * rsv); wv.z = pg8::cvt_pk_bf16(o[4] * rsv, o[5] * rsv); wv.w = pg8::cvt_pk_bf16(o[6] * rsv, o[7] * rsv);
                    *(v4u*)(hbase + (size_t)(i4 + k) * DM + 8 * l) = wv;
                }
            }
        }
    }
}

__device__ __forceinline__ void phase_conv(const Ctx& C0, int layer) {
    Ctx C = C0; C.lane = fresh_lane(); C.tid = C.wave * 64 + C.lane;
    const float* cw = C.ffn_conv_w + (size_t)layer * 3 * F2; const float* cb = C.ffn_conv_b + (size_t)layer * F2;
    constexpr int NCH = FF / 8;
    for (int idx = C.bid * NTHR + C.tid; idx < (MTOK / 16) * NCH; idx += C.G * NTHR) {
        const int ch = idx % NCH, tb = idx / NCH, t0 = tb * 16, c0 = ch * 8;
        float wg[3][8], wu[3][8], bg[8], bu[8], g2[8], g1[8], u2[8], u1[8];
#pragma unroll
        for (int j = 0; j < 3; ++j)
#pragma unroll
            for (int q = 0; q < 8; ++q) { wg[j][q] = cw[(size_t)j * F2 + c0 + q]; wu[j][q] = cw[(size_t)j * F2 + FF + c0 + q]; }
#pragma unroll
        for (int q = 0; q < 8; ++q) { bg[q] = cb[c0 + q]; bu[q] = cb[FF + c0 + q]; g2[q] = g1[q] = u2[q] = u1[q] = 0.f; }
        if ((t0 & (SEQ - 1)) != 0) {
            const v4u a = *(const v4u*)(C.HC + (size_t)(t0 - 2) * F2 + c0), bq = *(const v4u*)(C.HC + (size_t)(t0 - 1) * F2 + c0);
            const v4u cq = *(const v4u*)(C.HC + (size_t)(t0 - 2) * F2 + FF + c0), dq = *(const v4u*)(C.HC + (size_t)(t0 - 1) * F2 + FF + c0);
            g2[0] = bflo(a.x); g2[1] = bfhi(a.x); g2[2] = bflo(a.y); g2[3] = bfhi(a.y); g2[4] = bflo(a.z); g2[5] = bfhi(a.z); g2[6] = bflo(a.w); g2[7] = bfhi(a.w);
            g1[0] = bflo(bq.x); g1[1] = bfhi(bq.x); g1[2] = bflo(bq.y); g1[3] = bfhi(bq.y); g1[4] = bflo(bq.z); g1[5] = bfhi(bq.z); g1[6] = bflo(bq.w); g1[7] = bfhi(bq.w);
            u2[0] = bflo(cq.x); u2[1] = bfhi(cq.x); u2[2] = bflo(cq.y); u2[3] = bfhi(cq.y); u2[4] = bflo(cq.z); u2[5] = bfhi(cq.z); u2[6] = bflo(cq.w); u2[7] = bfhi(cq.w);
            u1[0] = bflo(dq.x); u1[1] = bfhi(dq.x); u1[2] = bflo(dq.y); u1[3] = bfhi(dq.y); u1[4] = bflo(dq.z); u1[5] = bfhi(dq.z); u1[6] = bflo(dq.w); u1[7] = bfhi(dq.w);
        }
#pragma unroll 4
        for (int q = 0; q < 16; ++q) {
            const v4u a = *(const v4u*)(C.HC + (size_t)(t0 + q) * F2 + c0), bq = *(const v4u*)(C.HC + (size_t)(t0 + q) * F2 + FF + c0);
            float gc[8], uc[8], o[8];
            gc[0] = bflo(a.x); gc[1] = bfhi(a.x); gc[2] = bflo(a.y); gc[3] = bfhi(a.y); gc[4] = bflo(a.z); gc[5] = bfhi(a.z); gc[6] = bflo(a.w); gc[7] = bfhi(a.w);
            uc[0] = bflo(bq.x); uc[1] = bfhi(bq.x); uc[2] = bflo(bq.y); uc[3] = bfhi(bq.y); uc[4] = bflo(bq.z); uc[5] = bfhi(bq.z); uc[6] = bflo(bq.w); uc[7] = bfhi(bq.w);
#pragma unroll
            for (int k = 0; k < 8; ++k) { const float gv = bg[k] + wg[0][k] * g2[k] + wg[1][k] * g1[k] + wg[2][k] * gc[k]; const float uv = bu[k] + wu[0][k] * u2[k] + wu[1][k] * u1[k] + wu[2][k] * uc[k];
                o[k] = gv / (1.0f + expf(-gv)) * uv; g2[k] = g1[k]; g1[k] = gc[k]; u2[k] = u1[k]; u1[k] = uc[k]; }
            v4u w; w.x = pk2(o[0], o[1]); w.y = pk2(o[2], o[3]); w.z = pk2(o[4], o[5]); w.w = pk2(o[6], o[7]);
            *(v4u*)(C.ACT + (size_t)(t0 + q) * FF + c0) = w;
        }
    }
}

__device__ __forceinline__ void phase_kmean(const Ctx& C0) {
    Ctx C = C0; C.lane = fresh_lane(); C.tid = C.wave * 64 + C.lane;
    LAS float* red = (LAS float*)C.lds;
    const int tid = C.tid, dch = tid & 15, kg = tid >> 4;
    for (int u = C.bid; u < 2048; u += C.G) {
        const int bh = u >> 5, n = u & 31, b = bh >> 5, h = bh & 31;
        float s[8];
#pragma unroll
        for (int j = 0; j < 8; ++j) s[j] = 0.f;
#pragma unroll
        for (int i = 0; i < 8; ++i) { const int key = kg + 32 * i; const v4u x = *(const v4u*)(C.PROJ + (size_t)(b * SEQ + n * 256 + key) * NPROJ + 4096 + h * 128 + dch * 8);
            s[0] += bflo(x.x); s[1] += bfhi(x.x); s[2] += bflo(x.y); s[3] += bfhi(x.y); s[4] += bflo(x.z); s[5] += bfhi(x.z); s[6] += bflo(x.w); s[7] += bfhi(x.w); }
        __syncthreads();
#pragma unroll
        for (int j = 0; j < 8; ++j) red[kg * 128 + dch * 8 + j] = s[j];
        __syncthreads();
        if (tid < 128) { float t = 0.f; for (int k = 0; k < 32; ++k) t += red[k * 128 + tid]; C.KM[(size_t)u * 128 + tid] = t * (1.0f / 256.0f); }
    }
}
#define TOP3_INS(s_, n_) do { const float _s = (s_); const unsigned _n = (n_); \
    if (_s > v0 || (_s == v0 && _n < i0)) { v2 = v1; i2 = i1; v1 = v0; i1 = i0; v0 = _s; i0 = _n; } \
    else if (_s > v1 || (_s == v1 && _n < i1)) { v2 = v1; i2 = i1; v1 = _s; i1 = _n; } \
    else if (_s > v2 || (_s == v2 && _n < i2)) { v2 = _s; i2 = _n; } } while (0)
__device__ __forceinline__ void phase_gating(const Ctx& C0) {
    Ctx C = C0; C.lane = fresh_lane(); C.tid = C.wave * 64 + C.lane;
    LAS unsigned char* KH = C.lds;
    LAS unsigned char* KLo = C.lds + 8704;
    const int tid = C.tid, l = C.lane, jq = l & 15, g = l >> 4, w = C.wave;
    for (int u = C.bid; u < 2048; u += C.G) {
        const int bh = u >> 5, qb = u & 31, b = bh >> 5, h = bh & 31;
        __syncthreads();
        for (int i = tid; i < 2048; i += 512) { const f32x2 va = *(const f32x2*)(C.KM + (size_t)bh * 4096 + 2 * i), vb = *(const f32x2*)(C.KM + (size_t)(64 * 32 * 128) + (size_t)bh * 4096 + 2 * i);
            const f32x2 v = (va + vb) * (1.0f / 256.0f); const int n = i >> 6, d = (i & 63) * 2;
            const unsigned hx = f2bf(v.x), hy = f2bf(v.y); const float rx = v.x - __uint_as_float(hx << 16), ry = v.y - __uint_as_float(hy << 16);
            *(LAS unsigned*)(KH + n * 272 + d * 2) = hx | (hy << 16); *(LAS unsigned*)(KLo + n * 272 + d * 2) = pk2(rx, ry); }
        __syncthreads();
#pragma unroll 1
        for (int qt = 0; qt < 2; ++qt) {
            const int t = qb * 256 + w * 32 + qt * 16 + jq;
            const bf16* qrow = C.PROJ + hm_off(0, b, h, t) + g * 8;
            f32x4 a0 = {0.f, 0.f, 0.f, 0.f}, a1 = {0.f, 0.f, 0.f, 0.f};
#pragma unroll
            for (int s = 0; s < 4; ++s) { const bf16x8 qf = *(const bf16x8*)(qrow + 32 * s);
                a0 = mfma16(*(const LAS bf16x8*)(KH + jq * 272 + s * 64 + g * 16), qf, a0); a1 = mfma16(*(const LAS bf16x8*)(KH + (16 + jq) * 272 + s * 64 + g * 16), qf, a1);
                a0 = mfma16(*(const LAS bf16x8*)(KLo + jq * 272 + s * 64 + g * 16), qf, a0); a1 = mfma16(*(const LAS bf16x8*)(KLo + (16 + jq) * 272 + s * 64 + g * 16), qf, a1); }
            float v0 = -INFINITY, v1 = -INFINITY, v2 = -INFINITY; unsigned i0 = 0xFFu, i1 = 0xFFu, i2 = 0xFFu;
#pragma unroll
            for (int r = 0; r < 4; ++r) { const int n = 4 * g + r; if (n < qb) TOP3_INS(a0[r], (unsigned)n); }
#pragma unroll
            for (int r = 0; r < 4; ++r) { const int n = 16 + 4 * g + r; if (n < qb) TOP3_INS(a1[r], (unsigned)n); }
#pragma unroll
            for (int sh = 16; sh <= 32; sh <<= 1) {
                const float p0 = __shfl_xor(v0, sh), p1 = __shfl_xor(v1, sh), p2 = __shfl_xor(v2, sh);
                const unsigned j0 = (unsigned)__shfl_xor((int)i0, sh), j1 = (unsigned)__shfl_xor((int)i1, sh), j2 = (unsigned)__shfl_xor((int)i2, sh);
                if (j0 != 0xFFu) TOP3_INS(p0, j0);
                if (j1 != 0xFFu) TOP3_INS(p1, j1);
                if (j2 != 0xFFu) TOP3_INS(p2, j2);
            }
            if (g == 0) C.SEL[(size_t)bh * SEQ + t] = (int)(i0 | (i1 << 8) | (i2 << 16));
        }
    }
}
__device__ __forceinline__ void moba_tile(const Ctx& C, LAS unsigned char* KL, LAS unsigned char* VT, int b, int h, int ent, bf16x8 (&qf)[4], const bf16x8 (&qn)[4], int nkt, bool causal, int blk0) {
    const int l = C.lane, jq = l & 15, g = l >> 4, gs = g ^ (((jq + 4) >> 3) & 1);
    const int t = ent & 0xFFFF, slot = (ent >> 16) & 3; const bool valid = ent >= 0;
    f32x4 st[16];
    constexpr float SCALE = 0.08838834764831845f, C2 = 0.08838834764831845f * 1.4426950408889634f;
    const int tq = t - blk0, npair = (nkt + 1) >> 1, dq = tq - 4 * g;
    float m = -INFINITY;
#pragma unroll
    for (int kp = 0; kp < 8; ++kp) {
        if (kp < npair) {
            bf16x8 k0[4], k1[4];
#pragma unroll
            for (int s = 0; s < 4; ++s) { k0[s] = *(const LAS bf16x8*)(KL + (32 * kp + jq) * 272 + s * 64 + gs * 16); k1[s] = *(const LAS bf16x8*)(KL + (32 * kp + 16 + jq) * 272 + s * 64 + gs * 16); }
            f32x4 a0 = {0.f, 0.f, 0.f, 0.f}, a1 = {0.f, 0.f, 0.f, 0.f};
#pragma unroll
            for (int s = 0; s < 4; ++s) { a0 = mfma16(k0[s], qf[s], a0); a1 = mfma16(k1[s], qf[s], a1); }
            if (causal && kp == npair - 1) {
#pragma unroll
                for (int r = 0; r < 4; ++r) { if (32 * kp + r > dq) a0[r] = -INFINITY; if (32 * kp + 16 + r > dq) a1[r] = -INFINITY; }
            }
            m = fmaxf(m, fmaxf(fmaxf(a0[0], a0[1]), fmaxf(a0[2], a0[3]))); m = fmaxf(m, fmaxf(fmaxf(a1[0], a1[1]), fmaxf(a1[2], a1[3])));
            st[2 * kp] = a0; st[2 * kp + 1] = a1;
        } else { st[2 * kp] = (f32x4){0.f, 0.f, 0.f, 0.f}; st[2 * kp + 1] = (f32x4){0.f, 0.f, 0.f, 0.f}; }
        __builtin_amdgcn_sched_barrier(0);
    }
    m = fmaxf(m, __shfl_xor(m, 16)); m = fmaxf(m, __shfl_xor(m, 32));
    const float mc = m * C2;
    float lsum = 0.f;
    f32x4 oacc[8];
#pragma unroll
    for (int et = 0; et < 8; ++et) oacc[et] = (f32x4){0.f, 0.f, 0.f, 0.f};
#pragma unroll
    for (int ks = 0; ks < 8; ++ks) {
        if (ks < npair) {
            float p[8];
#pragma unroll
            for (int r = 0; r < 4; ++r) { p[r] = __builtin_amdgcn_exp2f(st[2 * ks][r] * C2 - mc); p[4 + r] = __builtin_amdgcn_exp2f(st[2 * ks + 1][r] * C2 - mc); }
            lsum += ((p[0] + p[1]) + (p[2] + p[3])) + ((p[4] + p[5]) + (p[6] + p[7]));
            v4u pbu; pbu.x = pg8::cvt_pk_bf16(p[0], p[1]); pbu.y = pg8::cvt_pk_bf16(p[2], p[3]); pbu.z = pg8::cvt_pk_bf16(p[4], p[5]); pbu.w = pg8::cvt_pk_bf16(p[6], p[7]);
            const bf16x8 pb = __builtin_bit_cast(bf16x8, pbu);
            bf16x8 va[8];
#pragma unroll
            for (int et = 0; et < 8; ++et) va[et] = *(const LAS bf16x8*)(VT + (16 * et + jq) * 528 + ks * 64 + gs * 16);
#pragma unroll
            for (int et = 0; et < 8; ++et) oacc[et] = mfma16(va[et], pb, oacc[et]);
        }
        __builtin_amdgcn_sched_barrier(0);
    }
    lsum += __shfl_xor(lsum, 16); lsum += __shfl_xor(lsum, 32);
#pragma unroll
    for (int s4 = 0; s4 < 4; ++s4) qf[s4] = qn[s4];
    __builtin_amdgcn_sched_barrier(0);
    if (causal) {
        const int nv = (blk0 >> 8) < 3 ? (blk0 >> 8) : 3; const size_t tok = (size_t)b * SEQ + t;
        f32x2 mlv[3]; v2u xs[3][8];
#pragma unroll
        for (int s = 0; s < 3; ++s) { mlv[s] = *(const f32x2*)(C.ML + hm_off(s, b, h, t) / 64); const bf16* pp = C.PART + hm_off(s, b, h, t) + 4 * g;
#pragma unroll
            for (int et = 0; et < 8; ++et) xs[s][et] = *(const v2u*)(pp + 16 * et); }
        const float mo = m * SCALE; float M = mo; float ms[3], ls[3];
#pragma unroll
        for (int s = 0; s < 3; ++s) { ms[s] = (s < nv) ? mlv[s].x : -INFINITY; ls[s] = (s < nv) ? mlv[s].y : 0.f; M = fmaxf(M, ms[s]); }
        const float wo = __builtin_amdgcn_exp2f((mo - M) * 1.4426950408889634f); float W = lsum * wo;
#pragma unroll
        for (int et = 0; et < 8; ++et) oacc[et] = oacc[et] * wo;
#pragma unroll
        for (int s = 0; s < 3; ++s) {
            const float ws = (s < nv) ? __builtin_amdgcn_exp2f((ms[s] - M) * 1.4426950408889634f) * ls[s] : 0.f; W += ws;
#pragma unroll
            for (int et = 0; et < 8; ++et) { const unsigned xa = (s < nv) ? xs[s][et].x : 0u, xb = (s < nv) ? xs[s][et].y : 0u;
                oacc[et][0] += ws * bflo(xa); oacc[et][1] += ws * bfhi(xa); oacc[et][2] += ws * bflo(xb); oacc[et][3] += ws * bfhi(xb); }
        }
        const float inv = __builtin_amdgcn_rcpf(W);
#pragma unroll
        for (int et = 0; et < 8; ++et) { v2u o; o.x = pg8::cvt_pk_bf16(oacc[et][0] * inv, oacc[et][1] * inv); o.y = pg8::cvt_pk_bf16(oacc[et][2] * inv, oacc[et][3] * inv);
            *(v2u*)(C.HG + tok * DM + h * 128 + 16 * et + 4 * g) = o; }
    } else if (valid) {
        const float inv = __builtin_amdgcn_rcpf(lsum); const size_t prow = hm_off(slot, b, h, t);
#pragma unroll
        for (int et = 0; et < 8; ++et) { v2u o; o.x = pg8::cvt_pk_bf16(oacc[et][0] * inv, oacc[et][1] * inv); o.y = pg8::cvt_pk_bf16(oacc[et][2] * inv, oacc[et][3] * inv);
            *(v2u*)(C.PART + prow + 16 * et + 4 * g) = o; }
        if (g == 0) *(f32x2*)(C.ML + prow / 64) = (f32x2){m * SCALE, lsum};
    }
}
__device__ __forceinline__ void phase_moba_attn(const Ctx& C0, int rep, const XcdBarrier& bar) {
    Ctx C = C0; C.lane = fresh_lane(); C.tid = C.wave * 64 + C.lane;
    LAS unsigned char* KL = C.lds;
    LAS unsigned char* VT = C.lds + 69632;
    LAS int* LIST = (LAS int*)(C.lds + 137216);
    LAS int* cnt = (LAS int*)(C.lds + 153600);
    volatile LAS int* wq = (volatile LAS int*)(C.lds + 153604);
    const int tid = C.tid, l = C.lane, w = C.wave, jq = l & 15, g = l >> 4;
    constexpr int NSEL = 31 * 64, NOWN = 32 * 64;
#ifndef MOBA_REPS
#define MOBA_REPS 1
#endif
    int pass = 0, own_i = C.bid, rr = 0;
    for (;;) {
        int item;
        if (pass == 0) {
            __syncthreads();
            if (tid == 0) *wq = (int)__hip_atomic_fetch_add(C.ctl + CW_WQ + 64 * (rep + 2 * rr), 1u, RLX_AGENT);
            __syncthreads();
            item = *wq;
            if (item >= NSEL) { xcd_barrier(bar); pass = 1; continue; }
        } else {
            if (own_i >= NOWN) { if (++rr < MOBA_REPS) { xcd_barrier(bar); pass = 0; own_i = C.bid; continue; } break; }
            item = NSEL + own_i; own_i += C.G;
            __syncthreads();
        }
        const bool selu = item < NSEL;
        const int n = selu ? (item >> 6) : ((item - NSEL) >> 6), bh = item & 63, b = bh >> 5, h = bh & 31;
        { const bf16* krow0 = C.PROJ + hm_off(1, b, h, n * 256);
          int tid = C.tid; asm volatile("" : "+v"(tid));
          v4u kk[8];
#pragma unroll
          for (int it = 0; it < 8; ++it) { const int q = tid + 512 * it, key = q >> 4, ch = q & 15; kk[it] = *(const v4u*)(krow0 + key * 128 + ch * 8); }
          const int key = tid & 255, cg = tid >> 8; const bf16* vrow = C.PROJ + hm_off(2, b, h, n * 256 + key); LAS bf16* vt = (LAS bf16*)VT;
          v4u vv[8];
#pragma unroll
          for (int k = 0; k < 8; ++k) vv[k] = *(const v4u*)(vrow + (cg + 2 * k) * 8);
#pragma unroll
          for (int it = 0; it < 8; ++it) { const int q = tid + 512 * it, key2 = q >> 4, ch = (q & 15) ^ (((key2 + 4) >> 3) & 1); *(LAS v4u*)(KL + key2 * 272 + ch * 16) = kk[it]; }
          const int keyp = (key & ~31) + 8 * ((key & 15) >> 2) + 4 * ((key >> 4) & 1) + (key & 3);
#pragma unroll
          for (int k = 0; k < 8; ++k) { const int ch = cg + 2 * k; const v4u x = vv[k]; const int e8 = (ch & 1) * 8;
              LAS bf16* dstA = vt + (ch * 8) * 264 + keyp;
              LAS bf16* dstB = vt + (ch * 8) * 264 + (keyp ^ 8);
              LAS bf16* d0 = e8 ? dstB : dstA; LAS bf16* d1 = e8 ? dstA : dstB;
              d0[0 * 264] = (bf16)(x.x & 0xffffu); d0[1 * 264] = (bf16)(x.x >> 16); d0[2 * 264] = (bf16)(x.y & 0xffffu); d0[3 * 264] = (bf16)(x.y >> 16);
              d1[4 * 264] = (bf16)(x.z & 0xffffu); d1[5 * 264] = (bf16)(x.z >> 16); d1[6 * 264] = (bf16)(x.w & 0xffffu); d1[7 * 264] = (bf16)(x.w >> 16); } }
        const int tstart = (n + 1) * 256, nbatch = selu ? ((SEQ - tstart + 4095) >> 12) : 1;
        for (int bi = 0; bi < nbatch; ++bi) {
            int count = 256;
            if (selu) {
                __syncthreads();
                if (tid == 0) *cnt = 0;
                __syncthreads();
                const int b0 = tstart + bi * 4096, b1 = (b0 + 4096 < SEQ) ? b0 + 4096 : SEQ;
                int sel[8];
#pragma unroll
                for (int it = 0; it < 8; ++it) { const int t = b0 + it * 512 + tid; sel[it] = (t < b1) ? C.SEL[(size_t)bh * SEQ + t] : 0x00FFFFFF; }
#pragma unroll
                for (int it = 0; it < 8; ++it) { const int t = b0 + it * 512 + tid;
                    int slot = -1;
                    if ((sel[it] & 255) == n) slot = 0; else if (((sel[it] >> 8) & 255) == n) slot = 1; else if (((sel[it] >> 16) & 255) == n) slot = 2;
                    const bool match = slot >= 0;
                    const unsigned long long mask = __ballot(match);
                    if (mask) { int base = 0; if (l == 0) base = __hip_atomic_fetch_add(cnt, (int)__popcll(mask), __ATOMIC_RELAXED, __HIP_MEMORY_SCOPE_WORKGROUP);
                        base = __builtin_amdgcn_readfirstlane(base);
                        if (match) LIST[base + __popcll(mask & ((1ull << l) - 1ull))] = t | (slot << 16); } }
                __syncthreads();
                count = *cnt;
            } else __syncthreads();
            const int ntile = (count + 15) >> 4;
            int ti = w - 8;
            int ent = (int)0x80000000;
            bf16x8 qf[4], qn[4];
#pragma unroll
            for (int s4 = 0; s4 < 4; ++s4) { qf[s4] = (bf16x8){0, 0, 0, 0, 0, 0, 0, 0}; qn[s4] = qf[s4]; }
            for (;;) {
                const int tn = ti + 8; int entn = (int)0x80000000;
                const int tno = (tn < 8) ? tn : 23 - tn;
                if (tn < ntile) { entn = selu ? ((16 * tn + jq < count) ? LIST[16 * tn + jq] : (int)0x80000000) : ((n * 256 + 16 * tno + jq) | (3 << 16));
                    const bf16* qrow = C.PROJ + hm_off(0, b, h, entn & 0xFFFF) + g * 8;
#pragma unroll
                    for (int s4 = 0; s4 < 4; ++s4) qn[s4] = *(const bf16x8*)(qrow + 32 * s4); }
                if (ti >= 0) moba_tile(C, KL, VT, b, h, ent, qf, qn, selu ? 16 : ((ti < 8) ? ti : 23 - ti) + 1, !selu, n * 256);
                else {
#pragma unroll
                    for (int s4 = 0; s4 < 4; ++s4) qf[s4] = qn[s4]; }
                if (tn >= ntile) break;
                ent = entn; ti = tn;
            }
        }
    }
}
__device__ __forceinline__ void phase_moba_combine(const Ctx& C0) {
    Ctx C = C0; C.lane = fresh_lane(); C.tid = C.wave * 64 + C.lane;
    for (int idx = C.bid * NTHR + C.tid; idx < MTOK * 32 * 16; idx += C.G * NTHR) {
        const int ch = idx & 15, h = (idx >> 4) & 31, tok = idx >> 9, qb = (tok & (SEQ - 1)) >> 8, nv = qb < 3 ? qb : 3;
        float mm[4], ll[4], wgt[4];
        { const f32x2 v = *(const f32x2*)(C.ML + (((size_t)3 * MTOK + tok) * 32 + h) * 2); mm[3] = v.x; ll[3] = v.y; }
        float M = mm[3];
#pragma unroll
        for (int s = 0; s < 3; ++s) { if (s < nv) { const f32x2 v = *(const f32x2*)(C.ML + (((size_t)s * MTOK + tok) * 32 + h) * 2); mm[s] = v.x; ll[s] = v.y; M = fmaxf(M, v.x); } else { mm[s] = -INFINITY; ll[s] = 0.f; } }
        float W = 0.f;
#pragma unroll
        for (int s = 0; s < 4; ++s) { wgt[s] = (s == 3 || s < nv) ? expf(mm[s] - M) * ll[s] : 0.f; W += wgt[s]; }
        const float iw = 1.0f / W;
        float o[8];
#pragma unroll
        for (int j = 0; j < 8; ++j) o[j] = 0.f;
#pragma unroll
        for (int s = 0; s < 4; ++s) {
            if (s == 3 || s < nv) { const v4u x = *(const v4u*)(C.PART + ((size_t)s * MTOK + tok) * DM + h * 128 + ch * 8); const float ws = wgt[s] * iw;
                o[0] += ws * bflo(x.x); o[1] += ws * bfhi(x.x); o[2] += ws * bflo(x.y); o[3] += ws * bfhi(x.y); o[4] += ws * bflo(x.z); o[5] += ws * bfhi(x.z); o[6] += ws * bflo(x.w); o[7] += ws * bfhi(x.w); }
        }
        v4u wv; wv.x = pk2(o[0], o[1]); wv.y = pk2(o[2], o[3]); wv.z = pk2(o[4], o[5]); wv.w = pk2(o[6], o[7]);
        *(v4u*)(C.HG + (size_t)tok * DM + h * 128 + ch * 8) = wv;
    }
}

struct Args { const float* in[14]; float* out; unsigned char* ws; int ph_lo, ph_hi; };
__global__ void __launch_bounds__(NTHR, 2) hybrid_fwd(Args args) {
    extern __shared__ __attribute__((aligned(16))) unsigned char lds_raw[];
    Ctx C;
    C.lds = (LAS unsigned char*)lds_raw;
    C.tid = threadIdx.x; C.lane = C.tid & 63; C.wave = __builtin_amdgcn_readfirstlane(C.tid >> 6); C.G = gridDim.x; C.bid = blockIdx.x;
    C.x = args.in[0]; C.norm_mix = args.in[1]; C.norm_ffn = args.in[2]; C.a_w_in = args.in[3]; C.a_gate_bias = args.in[4]; C.a_head_norm = args.in[5]; C.a_w_out = args.in[6];
    C.b_w_qkv = args.in[7]; C.b_w_out = args.in[8]; C.ffn_w_up = args.in[9]; C.ffn_conv_w = args.in[10]; C.ffn_conv_b = args.in[11]; C.ffn_w_down = args.in[12]; C.final_norm = args.in[13];
    C.out = args.out;
    unsigned char* ws = args.ws;
    C.ctl = (unsigned*)(ws + WS_CTL);
    C.Win = (bf16*)(ws + WS_WIN); C.Wg = (bf16*)(ws + WS_WG); C.Wao = (bf16*)(ws + WS_WAO); C.Wqkv = (bf16*)(ws + WS_WQKV); C.Wbo = (bf16*)(ws + WS_WBO);
    C.Wup0 = (bf16*)(ws + WS_WUP0); C.Wup1 = (bf16*)(ws + WS_WUP1); C.Wdn0 = (bf16*)(ws + WS_WDN0); C.Wdn1 = (bf16*)(ws + WS_WDN1);
    C.X = (float*)(ws + WS_X); C.XN = (bf16*)(ws + WS_XN); C.HG = (bf16*)(ws + WS_HG);
    C.GATES = (float*)(ws + WS_GATES); C.FA = (float*)(ws + WS_FA); C.FG = (float*)(ws + WS_FG); C.FFv = (float*)(ws + WS_FF); C.KM = (float*)(ws + WS_KM); C.ML = (float*)(ws + WS_ML); C.SEL = (int*)(ws + WS_SEL);
    C.PROJ = (bf16*)(ws + WS_PROJ); C.UT = (bf16*)(ws + WS_UT); C.ST = (bf16*)(ws + WS_ST); C.HC = (bf16*)(ws + WS_HC); C.ACT = (bf16*)(ws + WS_ACT); C.PART = (bf16*)(ws + WS_PART);
    C.HALO = (float*)(ws + WS_HC); C.HEAD = (float*)(ws + WS_HC + 16 * MiB); C.SS = (float*)(ws + WS_SS); C.Xb = (bf16*)(ws + WS_X);
    C.A8 = (signed char*)(ws + WS_XN); C.Wao8 = (signed char*)(ws + WS_WAO); C.Wqkv8 = (signed char*)(ws + WS_WQKV); C.Wbo8 = (signed char*)(ws + WS_WBO); C.Wup08 = (signed char*)(ws + WS_WUP0); C.Wup18 = (signed char*)(ws + WS_WUP1); C.Wdn08 = (signed char*)(ws + WS_WDN0); C.Wdn18 = (signed char*)(ws + WS_WDN1); C.ACT8 = (signed char*)(ws + WS_BIG + 64 * MiB); C.Win8 = (signed char*)(ws + WS_WIN + 64 * MiB); C.XN8 = (signed char*)(ws + WS_HG); C.SA = (float*)(ws + WS_SA);

    volatile LAS unsigned* MISC = (volatile LAS unsigned*)(C.lds + MISC_OFF);
    if (C.tid < 64) MISC[C.tid] = 0u;
    __syncthreads();
    const int lo = args.ph_lo, hi = args.ph_hi;
    XcdBarrier bar; bar.bar = C.ctl + CW_BAR; bar.x = 0; bar.st = nullptr;
    if (hi - lo > 1) bar = xcd_barrier_post(C.ctl + CW_BAR, MISC + 8);
#ifdef ONLY_PHASE
#define IN(k) ((k) == ONLY_PHASE && lo <= (k) && (k) < hi)
#else
#define IN(k) (lo <= (k) && (k) < hi)
#endif
#define SEAM(k) do { if (IN(k) && IN((k) + 1)) xcd_barrier(bar); } while (0)
#ifndef REP_MASK
#define REP_MASK 0u
#endif
#define REPS(k) ((((REP_MASK) >> (k)) & 1u) ? 2 : 1)
#define REPSEAM(k, rep) do { if ((rep) + 1 < REPS(k)) xcd_barrier(bar); } while (0)

    if (IN(0)) { { const int rep = 0; (void)rep; phase_prologue(C); } if (REPS(0) == 2) { xcd_barrier(bar); { const int rep = 1; (void)rep; phase_prologue(C); } } } SEAM(0);
    phase_quant_weights(C); __syncthreads();
    if (IN(1)) { { const int rep = 0; (void)rep; { EpiStoreBf16 E{C.PROJ, NPROJ, nullptr, nullptr}; run_gemm(C, C.XN, C.Win, 8192, DM, E); } __syncthreads(); { EpiStoreBf16I8 E8{C.PROJ + 8192, NPROJ, nullptr, nullptr, C.SA, C.ctl + CW_WMAX_INO}; run_gemm_i8(C, C.XN8, C.Win8, 4096, DM, E8); } phase_gates(C); } if (REPS(1) == 2) { xcd_barrier(bar); { const int rep = 1; (void)rep; { EpiStoreBf16 E{C.PROJ, NPROJ, nullptr, nullptr}; run_gemm(C, C.XN, C.Win, 8192, DM, E); } __syncthreads(); { EpiStoreBf16I8 E8{C.PROJ + 8192, NPROJ, nullptr, nullptr, C.SA, C.ctl + CW_WMAX_INO}; run_gemm_i8(C, C.XN8, C.Win8, 4096, DM, E8); } phase_gates(C); } } } SEAM(1);
    if (IN(2)) { { const int rep = 0; (void)rep; phase_gate_scan(C); } if (REPS(2) == 2) { xcd_barrier(bar); { const int rep = 1; (void)rep; phase_gate_scan(C); } } } SEAM(2);
    if (IN(3)) { { const int rep = 0; (void)rep; phase_mlstm_u(C); } if (REPS(3) == 2) { xcd_barrier(bar); { const int rep = 1; (void)rep; phase_mlstm_u(C); } } } SEAM(3);
    if (IN(4)) { { const int rep = 0; (void)rep; phase_mlstm_scan(C); } if (REPS(4) == 2) { xcd_barrier(bar); { const int rep = 1; (void)rep; phase_mlstm_scan(C); } } } SEAM(4);
    if (IN(5)) { { const int rep = 0; (void)rep; phase_mlstm_out(C); } if (REPS(5) == 2) { xcd_barrier(bar); { const int rep = 1; (void)rep; phase_mlstm_out(C); } } } SEAM(5);
    phase_quant_rows<false>(C, C.HG, C.A8, C.SA); xcd_barrier(bar);
    if (IN(6)) { { const int rep = 0; (void)rep; EpiResidBfI8 E{C.x, nullptr, C.Xb, C.SS, C.lds + 131072, C.SA, C.ctl + CW_WMAX_AO}; run_gemm_i8(C, C.A8, C.Wao8, DM, DM, E); } if (REPS(6) == 2) { xcd_barrier(bar); { const int rep = 1; (void)rep; EpiResidBfI8 E{C.x, nullptr, C.Xb, C.SS, C.lds + 131072, C.SA, C.ctl + CW_WMAX_AO}; run_gemm_i8(C, C.A8, C.Wao8, DM, DM, E); } } } SEAM(6);
    phase_quant_rows<true>(C, C.Xb, C.A8, C.SA); xcd_barrier(bar);
    if (IN(8)) { { const int rep = 0; (void)rep; EpiConvActI8 E{C.ACT, C.ffn_conv_w, C.ffn_conv_b, C.HALO, C.HEAD, C.lds + 131072, C.SS, C.SA, C.ctl + CW_WMAX_UP0}; run_gemm_i8(C, C.A8, C.Wup08, F2, DM, E); } if (REPS(8) == 2) { xcd_barrier(bar); { const int rep = 1; (void)rep; EpiConvActI8 E{C.ACT, C.ffn_conv_w, C.ffn_conv_b, C.HALO, C.HEAD, C.lds + 131072, C.SS, C.SA, C.ctl + CW_WMAX_UP0}; run_gemm_i8(C, C.A8, C.Wup08, F2, DM, E); } } } SEAM(8);
    if (IN(9)) { { const int rep = 0; (void)rep; phase_conv_fixup(C, 0); } if (REPS(9) == 2) { xcd_barrier(bar); { const int rep = 1; (void)rep; phase_conv_fixup(C, 0); } } } SEAM(9);
    phase_quant_act(C); xcd_barrier(bar);
    if (IN(10)) { { const int rep = 0; (void)rep; EpiResidBfI8 E{nullptr, C.Xb, C.Xb, C.SS, C.lds + 131072, C.SA, C.ctl + CW_WMAX_DN0}; run_gemm_i8(C, C.ACT8, C.Wdn08, DM, FF, E); } if (REPS(10) == 2) { xcd_barrier(bar); { const int rep = 1; (void)rep; EpiResidBfI8 E{nullptr, C.Xb, C.Xb, C.SS, C.lds + 131072, C.SA, C.ctl + CW_WMAX_DN0}; run_gemm_i8(C, C.ACT8, C.Wdn08, DM, FF, E); } } } SEAM(10);
    phase_quant_rows<true>(C, C.Xb, C.A8, C.SA); xcd_barrier(bar);
    if (IN(12)) { { const int rep = 0; (void)rep; EpiStoreBf16I8 E{C.PROJ, NPROJ, nullptr, C.KM, C.SA, C.ctl + CW_WMAX_QKV, true}; run_gemm_i8(C, C.A8, C.Wqkv8, NPROJ, DM, E); } if (REPS(12) == 2) { xcd_barrier(bar); { const int rep = 1; (void)rep; EpiStoreBf16I8 E{C.PROJ, NPROJ, nullptr, C.KM, C.SA, C.ctl + CW_WMAX_QKV, true}; run_gemm_i8(C, C.A8, C.Wqkv8, NPROJ, DM, E); } } } SEAM(12);
    if (IN(14)) { { const int rep = 0; (void)rep; phase_gating(C); } if (REPS(14) == 2) { xcd_barrier(bar); { const int rep = 1; (void)rep; phase_gating(C); } } } SEAM(14);
    if (IN(15)) { { const int rep = 0; (void)rep; phase_moba_attn(C, rep, bar); } if (REPS(15) == 2) { xcd_barrier(bar); { const int rep = 1; (void)rep; phase_moba_attn(C, rep, bar); } } } SEAM(15);
    phase_quant_rows<false>(C, C.HG, C.A8, C.SA); xcd_barrier(bar);
    if (IN(17)) { { const int rep = 0; (void)rep; EpiResidBfI8 E{nullptr, C.Xb, C.Xb, C.SS, C.lds + 131072, C.SA, C.ctl + CW_WMAX_BO}; run_gemm_i8(C, C.A8, C.Wbo8, DM, DM, E); } if (REPS(17) == 2) { xcd_barrier(bar); { const int rep = 1; (void)rep; EpiResidBfI8 E{nullptr, C.Xb, C.Xb, C.SS, C.lds + 131072, C.SA, C.ctl + CW_WMAX_BO}; run_gemm_i8(C, C.A8, C.Wbo8, DM, DM, E); } } } SEAM(17);
    phase_quant_rows<true>(C, C.Xb, C.A8, C.SA); xcd_barrier(bar);
    if (IN(19)) { { const int rep = 0; (void)rep; EpiConvActI8 E{C.ACT, C.ffn_conv_w + (size_t)3 * F2, C.ffn_conv_b + F2, C.HALO, C.HEAD, C.lds + 131072, C.SS, C.SA, C.ctl + CW_WMAX_UP1}; run_gemm_i8(C, C.A8, C.Wup18, F2, DM, E); } if (REPS(19) == 2) { xcd_barrier(bar); { const int rep = 1; (void)rep; EpiConvActI8 E{C.ACT, C.ffn_conv_w + (size_t)3 * F2, C.ffn_conv_b + F2, C.HALO, C.HEAD, C.lds + 131072, C.SS, C.SA, C.ctl + CW_WMAX_UP1}; run_gemm_i8(C, C.A8, C.Wup18, F2, DM, E); } } } SEAM(19);
    if (IN(20)) { { const int rep = 0; (void)rep; phase_conv_fixup(C, 1); } if (REPS(20) == 2) { xcd_barrier(bar); { const int rep = 1; (void)rep; phase_conv_fixup(C, 1); } } } SEAM(20);
    phase_quant_act(C); xcd_barrier(bar);
    if (IN(21)) { { const int rep = 0; (void)rep; EpiResidBfI8 E{nullptr, C.Xb, C.Xb, C.SS, C.lds + 131072, C.SA, C.ctl + CW_WMAX_DN1}; run_gemm_i8(C, C.ACT8, C.Wdn18, DM, FF, E); } if (REPS(21) == 2) { xcd_barrier(bar); { const int rep = 1; (void)rep; EpiResidBfI8 E{nullptr, C.Xb, C.Xb, C.SS, C.lds + 131072, C.SA, C.ctl + CW_WMAX_DN1}; run_gemm_i8(C, C.ACT8, C.Wdn18, DM, FF, E); } } } SEAM(21);
    if (IN(22)) { const int gw = C.bid * NWAVES + C.wave, NGW = C.G * NWAVES, ln22 = fresh_lane();
        for (int m = gw; m < MTOK; m += NGW) rms_row_bf16_to_f32(C.Xb + (size_t)m * DM, C.final_norm, C.out + (size_t)m * DM, ln22); }
#undef IN
#undef SEAM
}

extern "C" void kernel_launch(void* const* d_in, const int* in_sizes, int n_in, void* d_out, int out_size, void* d_ws, size_t ws_size, hipStream_t stream) {
    static int grid = 0;
    if (grid == 0) {
        if (n_in != 14 || out_size != MTOK * DM || ws_size < WS_END) { fprintf(stderr, "kernel_launch: unexpected shapes (n_in %d, out %d, ws %zu < %zu)\n", n_in, out_size, ws_size, (size_t)WS_END); grid = -1; return; }
        int dev = 0, cus = 0, per_cu = 0;
        if (hipGetDevice(&dev) != hipSuccess || hipDeviceGetAttribute(&cus, hipDeviceAttributeMultiprocessorCount, dev) != hipSuccess) { grid = -1; return; }
        if (hipFuncSetAttribute((const void*)hybrid_fwd, hipFuncAttributeMaxDynamicSharedMemorySize, LDS_BYTES) != hipSuccess) { fprintf(stderr, "kernel_launch: hipFuncSetAttribute failed\n"); grid = -1; return; }
        if (hipOccupancyMaxActiveBlocksPerMultiprocessor(&per_cu, (const void*)hybrid_fwd, NTHR, LDS_BYTES) != hipSuccess || per_cu < 1) fprintf(stderr, "kernel_launch: occupancy query reports %d\n", per_cu);
        (void)hipGetLastError();
        grid = cus;
    }
    if (grid < 0) return;
    if (hipMemsetAsync((char*)d_ws + WS_CTL, 0, CTL_ZERO_BYTES, stream) != hipSuccess) return;
    Args a{};
    for (int i = 0; i < 14; ++i) a.in[i] = (const float*)d_in[i];
    a.out = (float*)d_out; a.ws = (unsigned char*)d_ws;
#if MK_PER_PHASE
    for (int p = 0; p < NPHASE; ++p) { a.ph_lo = p; a.ph_hi = p + 1; hipLaunchKernelGGL(hybrid_fwd, dim3(grid), dim3(NTHR), LDS_BYTES, stream, a); }
#else
    a.ph_lo = 0; a.ph_hi = NPHASE;
    hipLaunchKernelGGL(hybrid_fwd, dim3(grid), dim3(NTHR), LDS_BYTES, stream, a);
#endif
    const hipError_t le = hipPeekAtLastError();
    if (le != hipSuccess) fprintf(stderr, "kernel_launch: launch failed: %s\n", hipGetErrorName(le));
}
```

```cpp
#include <hip/hip_runtime.h>
#include <cstdio>
#include <cstdint>
namespace pg8 {
#define PG8_LAS __attribute__((address_space(3)))
typedef unsigned short bf16_t;
typedef short bf16x8 __attribute__((ext_vector_type(8)));
typedef float f32x4 __attribute__((ext_vector_type(4)));
typedef unsigned u32x4 __attribute__((ext_vector_type(4)));
constexpr int BM = 256, BK = 64, HALF = 128, HTB = HALF * BK * 2  , STAGE_BYTES = 8 * HTB, NXCD = 8, WGM = 8;

__host__ __device__ __forceinline__ int lds_byte(int r, int c) { const int st = (r >> 4) * 2 + (c >> 5), rr = r & 15, cc = c & 31, ob = rr * 64 + cc * 2; return st * 1024 + (ob ^ (((ob >> 9) & 1) << 5)); }
__host__ __device__ __forceinline__ void stage_rc(int b, int& R, int& C) { const int st = b / 1024, sb = b % 1024, swz = sb ^ (((sb >> 9) & 1) << 5); R = (st >> 1) * 16 + swz / 64; C = (st & 1) * 32 + (swz % 64) / 2; }
__host__ __device__ __forceinline__ int perm32(int rho) { const int n = rho >> 4, i = rho & 15; return 8 * (i >> 2) + 4 * n + (i & 3); }

struct Unit { int pm, pn; };
struct Gemm { const bf16_t* A; const bf16_t* Bt; int M, N, K; };

struct StaticOrder {
    int nM, nN, nwg, G, c;
    __host__ __device__ void init(int M, int N, int G_, int c_) { nM = M / BM; nN = N / BM; nwg = nM * nN; G = G_; c = c_; }
    __host__ __device__ bool next(int i, Unit& u) const {
        const long L = (long)i * G + c; if (L >= nwg) return false;
        int wgid = (int)L; { const int q = nwg / NXCD, r = nwg % NXCD, xcd = wgid % NXCD, off = wgid / NXCD; wgid = (xcd < r ? xcd * (q + 1) : r * (q + 1) + (xcd - r) * q) + off; }
        const int nig = WGM * nN, gid = wgid / nig, fm = gid * WGM, gsz = (nM - fm) < WGM ? (nM - fm) : WGM;
        u.pm = fm + ((wgid % nig) % gsz); u.pn = (wgid % nig) / gsz; return true;
    }
    __device__ __forceinline__ void a_ready(const Unit&) const {}
    __device__ __forceinline__ void done(const Unit&) const {}
};
__device__ __forceinline__ unsigned cvt_pk_bf16(float lo, float hi) { unsigned r; asm volatile("v_cvt_pk_bf16_f32 %0, %1, %2" : "=v"(r) : "v"(lo), "v"(hi)); return r; }
typedef float f32x2 __attribute__((ext_vector_type(2)));
template <class Epi, class Sched, bool ALIGN_EPI = false, bool SP2 = false>
__device__ __forceinline__ void gemm_phase(PG8_LAS unsigned char* lds, const Gemm g, const Sched& S, const Epi& E) {
    const int tid = threadIdx.x, wid = __builtin_amdgcn_readfirstlane(tid >> 6), lane = tid & 63, wr = wid >> 2, wc = wid & 3, fr = lane & 15, fq = lane >> 4;
    const int K = g.K, nt = K / BK;
    unsigned voffA[2], voffB[2];
#pragma unroll
    for (int i = 0; i < 2; ++i) { int R, C; stage_rc(tid * 16 + i * 8192, R, C); const int Rb = Epi::PERM ? ((R & ~31) + perm32(R & 31)) : R;
        voffA[i] = (unsigned)(R * K + C) * 2u; voffB[i] = (unsigned)(Rb * K + C) * 2u; }
    const size_t kstep = (size_t)(BK * 2);
    const size_t hstep = (size_t)HALF * K * 2;
    const size_t tstep = 2 * hstep;
    const unsigned ldsw = (unsigned)wid * 1024u;
    const int aoff = lds_byte(wr * 64 + fr, fq * 8), boff = lds_byte(wc * 32 + fr, fq * 8);
#define PG8_SA(b, h) (((b) * 2 + (h)) * HTB)
#define PG8_SB(b, h) ((4 + (b) * 2 + (h)) * HTB)
#define PG8_STAGE(bufoff, gbase, voff) do { _Pragma("unroll") for (int _i = 0; _i < 2; ++_i) \
        __builtin_amdgcn_global_load_lds((const unsigned*)((const char*)(gbase) + (voff)[_i]), (PG8_LAS unsigned*)(lds + (bufoff) + ldsw + _i * 8192), 16, 0, 0); } while (0)
#define PG8_LDA(dst, b, h) do { _Pragma("unroll") for (int m = 0; m < 4; ++m) _Pragma("unroll") for (int k = 0; k < 2; ++k) dst[m][k] = *(const PG8_LAS bf16x8*)(lds + PG8_SA(b, h) + aoff + m * 2048 + k * 1024); } while (0)
#define PG8_LDB(dst, b, h) do { _Pragma("unroll") for (int n = 0; n < 2; ++n) _Pragma("unroll") for (int k = 0; k < 2; ++k) dst[n][k] = *(const PG8_LAS bf16x8*)(lds + PG8_SB(b, h) + boff + n * 2048 + k * 1024); } while (0)
#define PG8_MMA(ai, bj, At, Bt) do { __builtin_amdgcn_s_setprio(1); _Pragma("unroll") for (int m = 0; m < 4; ++m) _Pragma("unroll") for (int n = 0; n < 2; ++n) _Pragma("unroll") for (int k = 0; k < 2; ++k) \
        acc[ai][bj][m][n] = __builtin_amdgcn_mfma_f32_16x16x32_bf16(Bt[n][k], At[m][k], acc[ai][bj][m][n], 0, 0, 0); __builtin_amdgcn_s_setprio(0); } while (0)
#define PG8_WAIT_V(n) asm volatile("s_waitcnt vmcnt(" #n ")" ::: "memory")
#define PG8_WAIT_L(n) asm volatile("s_waitcnt lgkmcnt(" #n ")" ::: "memory")
#define PG8_BAR __builtin_amdgcn_s_barrier()
#define PG8_SCHED __builtin_amdgcn_sched_barrier(0)
    Unit cur, nxt; int ui = 0;
    if (!S.next(0, cur)) return;
    f32x4 acc[2][2][4][2];
#pragma unroll
    for (int a = 0; a < 2; ++a)
#pragma unroll
        for (int b = 0; b < 2; ++b)
#pragma unroll
            for (int m = 0; m < 4; ++m)
#pragma unroll
                for (int n = 0; n < 2; ++n) acc[a][b][m][n] = (f32x4){0.f, 0.f, 0.f, 0.f};
    bf16x8 At[4][2], B0[2][2], B1[2][2];
    const char* cA = (const char*)g.A + (size_t)cur.pm * tstep; const char* cB = (const char*)g.Bt + (size_t)cur.pn * tstep;
    S.a_ready(cur);
    if constexpr (SP2) {
        PG8_STAGE(PG8_SB(0, 0), cB, voffB); PG8_STAGE(PG8_SB(0, 1), cB + hstep, voffB); PG8_STAGE(PG8_SA(0, 0), cA, voffA); PG8_STAGE(PG8_SA(0, 1), cA + hstep, voffA);
        if (wr == 1) PG8_BAR;
        PG8_WAIT_V(2); PG8_BAR;
        PG8_STAGE(PG8_SB(1, 0), cB + kstep, voffB); PG8_STAGE(PG8_SA(1, 0), cA + kstep, voffA); PG8_STAGE(PG8_SB(1, 1), cB + hstep + kstep, voffB);
        PG8_WAIT_V(6); PG8_BAR;
    } else {
        PG8_STAGE(PG8_SB(0, 0), cB, voffB); PG8_STAGE(PG8_SA(0, 0), cA, voffA); PG8_STAGE(PG8_SB(0, 1), cB + hstep, voffB); PG8_STAGE(PG8_SA(0, 1), cA + hstep, voffA);
        if (wr == 1) PG8_BAR;
        PG8_WAIT_V(4); PG8_BAR;
        PG8_STAGE(PG8_SB(1, 0), cB + kstep, voffB); PG8_STAGE(PG8_SA(1, 0), cA + kstep, voffA); PG8_STAGE(PG8_SB(1, 1), cB + hstep + kstep, voffB);
        PG8_WAIT_V(6); PG8_BAR;
    }
    for (;;) {
        const bool has_next = S.next(ui + 1, nxt);
        const char* nA = has_next ? (const char*)g.A + (size_t)nxt.pm * tstep : cA; const char* nB = has_next ? (const char*)g.Bt + (size_t)nxt.pn * tstep : cB;
        for (int t = 0; t < nt; t += 2) {
            const bool last = (t == nt - 2);
            const char* a1 = cA + (size_t)(t + 1) * kstep;
            const char* a2 = last ? nA : cA + (size_t)(t + 2) * kstep; const char* b2 = last ? nB : cB + (size_t)(t + 2) * kstep;
            const char* a3 = a2 + kstep; const char* b3 = b2 + kstep;
            if (last && has_next) S.a_ready(nxt);
            if constexpr (SP2) {
            PG8_LDB(B0, 0, 0); PG8_LDB(B1, 0, 1); PG8_SCHED; PG8_LDA(At, 0, 0); PG8_STAGE(PG8_SA(1, 1), a1 + hstep, voffA);
            PG8_WAIT_V(8); PG8_WAIT_L(0); PG8_BAR; PG8_MMA(0, 0, At, B0); PG8_MMA(0, 1, At, B1); PG8_BAR; PG8_SCHED;
            PG8_LDA(At, 0, 1); PG8_STAGE(PG8_SB(0, 0), b2, voffB); PG8_STAGE(PG8_SB(0, 1), b2 + hstep, voffB); PG8_STAGE(PG8_SA(0, 0), a2, voffA);
            PG8_WAIT_V(8); PG8_WAIT_L(0); PG8_BAR; PG8_MMA(1, 0, At, B0); PG8_MMA(1, 1, At, B1); PG8_BAR; PG8_SCHED;
            PG8_LDB(B0, 1, 0); PG8_LDB(B1, 1, 1); PG8_SCHED; PG8_LDA(At, 1, 0); PG8_STAGE(PG8_SA(0, 1), a2 + hstep, voffA);
            PG8_WAIT_V(8); PG8_WAIT_L(0); PG8_BAR; PG8_MMA(0, 0, At, B0); PG8_MMA(0, 1, At, B1); PG8_BAR; PG8_SCHED;
            PG8_LDA(At, 1, 1); PG8_STAGE(PG8_SB(1, 0), b3, voffB); PG8_STAGE(PG8_SB(1, 1), b3 + hstep, voffB); PG8_STAGE(PG8_SA(1, 0), a3, voffA);
            PG8_WAIT_V(8); PG8_WAIT_L(0); PG8_BAR; PG8_MMA(1, 0, At, B0); PG8_MMA(1, 1, At, B1); PG8_BAR; PG8_SCHED;
            } else {
            PG8_LDB(B0, 0, 0); PG8_SCHED; PG8_LDA(At, 0, 0); PG8_STAGE(PG8_SA(1, 1), a1 + hstep, voffA);
            PG8_WAIT_L(8); PG8_BAR; PG8_WAIT_L(0); PG8_MMA(0, 0, At, B0); PG8_BAR; PG8_SCHED;
            PG8_LDB(B1, 0, 1); PG8_STAGE(PG8_SB(0, 0), b2, voffB);
            PG8_BAR; PG8_WAIT_L(0); PG8_MMA(0, 1, At, B1); PG8_BAR;
            PG8_LDA(At, 0, 1); PG8_STAGE(PG8_SA(0, 0), a2, voffA);
            PG8_BAR; PG8_WAIT_L(0); PG8_MMA(1, 0, At, B0); PG8_BAR; PG8_SCHED;
            PG8_STAGE(PG8_SB(0, 1), b2 + hstep, voffB);
            PG8_WAIT_V(6); PG8_BAR; PG8_MMA(1, 1, At, B1); PG8_BAR;
            PG8_LDB(B0, 1, 0); PG8_SCHED; PG8_LDA(At, 1, 0); PG8_STAGE(PG8_SA(0, 1), a2 + hstep, voffA);
            PG8_WAIT_L(8); PG8_BAR; PG8_WAIT_L(0); PG8_MMA(0, 0, At, B0); PG8_BAR; PG8_SCHED;
            PG8_LDB(B1, 1, 1); PG8_STAGE(PG8_SB(1, 0), b3, voffB);
            PG8_BAR; PG8_WAIT_L(0); PG8_MMA(0, 1, At, B1); PG8_BAR;
            PG8_LDA(At, 1, 1); PG8_STAGE(PG8_SA(1, 0), a3, voffA);
            PG8_BAR; PG8_WAIT_L(0); PG8_MMA(1, 0, At, B0); PG8_BAR; PG8_SCHED;
            PG8_STAGE(PG8_SB(1, 1), b3 + hstep, voffB);
            PG8_WAIT_V(6); PG8_BAR; PG8_MMA(1, 1, At, B1); PG8_BAR;
            }
        }
        if constexpr (ALIGN_EPI) { if (wr == 0) PG8_BAR; }
        if constexpr (!Epi::AFTER_DRAIN) { E(acc, cur, wr, wc, fr, fq); S.done(cur); }
        if (!has_next) break;
#pragma unroll
        for (int a = 0; a < 2; ++a)
#pragma unroll
            for (int b = 0; b < 2; ++b)
#pragma unroll
                for (int m = 0; m < 4; ++m)
#pragma unroll
                    for (int n = 0; n < 2; ++n) acc[a][b][m][n] = (f32x4){0.f, 0.f, 0.f, 0.f};
        cur = nxt; cA = nA; cB = nB; ++ui;
        if constexpr (ALIGN_EPI) { if (wr == 1) PG8_BAR; }
    }
    PG8_WAIT_V(0);
    if constexpr (!ALIGN_EPI) { if (wr == 0) PG8_BAR; }
    PG8_BAR;
    if constexpr (Epi::AFTER_DRAIN) { E.fused(acc, cur, wr, wc, fr, fq, lds, wid, lane); S.done(cur); }
#undef PG8_SA
#undef PG8_SB
#undef PG8_STAGE
#undef PG8_LDA
#undef PG8_LDB
#undef PG8_MMA
#undef PG8_WAIT_V
#undef PG8_WAIT_L
#undef PG8_BAR
#undef PG8_SCHED
}
typedef int i32x4 __attribute__((ext_vector_type(4)));
template <class Epi, class Sched, bool ALIGN_EPI = false, bool SP2 = false>
__device__ __forceinline__ void gemm_phase_i8(PG8_LAS unsigned char* lds, const Gemm g, const Sched& S, const Epi& E) {
    const int tid = threadIdx.x, wid = __builtin_amdgcn_readfirstlane(tid >> 6), lane = tid & 63, wr = wid >> 2, wc = wid & 3, fr = lane & 15, fq = lane >> 4;
    const int K = g.K, nt = K / BK;
    unsigned voffA[2], voffB[2];
#pragma unroll
    for (int i = 0; i < 2; ++i) { int R, C; stage_rc(tid * 16 + i * 8192, R, C); const int Rb = Epi::PERM ? ((R & ~31) + perm32(R & 31)) : R;
        voffA[i] = (unsigned)(R * K + C) * 2u; voffB[i] = (unsigned)(Rb * K + C) * 2u; }
    const size_t kstep = (size_t)(BK * 2);
    const size_t hstep = (size_t)HALF * K * 2;
    const size_t tstep = 2 * hstep;
    const unsigned ldsw = (unsigned)wid * 1024u;
    const int aoff = lds_byte(wr * 64 + fr, fq * 8), boff = lds_byte(wc * 32 + fr, fq * 8);
#define PG8_SA(b, h) (((b) * 2 + (h)) * HTB)
#define PG8_SB(b, h) ((4 + (b) * 2 + (h)) * HTB)
#define PG8_STAGE(bufoff, gbase, voff) do { _Pragma("unroll") for (int _i = 0; _i < 2; ++_i) \
        __builtin_amdgcn_global_load_lds((const unsigned*)((const char*)(gbase) + (voff)[_i]), (PG8_LAS unsigned*)(lds + (bufoff) + ldsw + _i * 8192), 16, 0, 0); } while (0)
#define PG8_LDA(dst, b, h) do { _Pragma("unroll") for (int m = 0; m < 4; ++m) _Pragma("unroll") for (int k = 0; k < 2; ++k) dst[m][k] = *(const PG8_LAS bf16x8*)(lds + PG8_SA(b, h) + aoff + m * 2048 + k * 1024); } while (0)
#define PG8_LDB(dst, b, h) do { _Pragma("unroll") for (int n = 0; n < 2; ++n) _Pragma("unroll") for (int k = 0; k < 2; ++k) dst[n][k] = *(const PG8_LAS bf16x8*)(lds + PG8_SB(b, h) + boff + n * 2048 + k * 1024); } while (0)
#define PG8_MMA(ai, bj, At, Bt) do { __builtin_amdgcn_s_setprio(1); _Pragma("unroll") for (int m = 0; m < 4; ++m) _Pragma("unroll") for (int n = 0; n < 2; ++n) _Pragma("unroll") for (int k = 0; k < 2; ++k) \
        acc[ai][bj][m][n] = __builtin_amdgcn_mfma_i32_16x16x64_i8(__builtin_bit_cast(i32x4, Bt[n][k]), __builtin_bit_cast(i32x4, At[m][k]), acc[ai][bj][m][n], 0, 0, 0); __builtin_amdgcn_s_setprio(0); } while (0)
#define PG8_WAIT_V(n) asm volatile("s_waitcnt vmcnt(" #n ")" ::: "memory")
#define PG8_WAIT_L(n) asm volatile("s_waitcnt lgkmcnt(" #n ")" ::: "memory")
#define PG8_BAR __builtin_amdgcn_s_barrier()
#define PG8_SCHED __builtin_amdgcn_sched_barrier(0)
    Unit cur, nxt; int ui = 0;
    if (!S.next(0, cur)) return;
    i32x4 acc[2][2][4][2];
#pragma unroll
    for (int a = 0; a < 2; ++a)
#pragma unroll
        for (int b = 0; b < 2; ++b)
#pragma unroll
            for (int m = 0; m < 4; ++m)
#pragma unroll
                for (int n = 0; n < 2; ++n) acc[a][b][m][n] = (i32x4){0, 0, 0, 0};
    bf16x8 At[4][2], B0[2][2], B1[2][2];
    const char* cA = (const char*)g.A + (size_t)cur.pm * tstep; const char* cB = (const char*)g.Bt + (size_t)cur.pn * tstep;
    S.a_ready(cur);
    if constexpr (SP2) {
        PG8_STAGE(PG8_SB(0, 0), cB, voffB); PG8_STAGE(PG8_SB(0, 1), cB + hstep, voffB); PG8_STAGE(PG8_SA(0, 0), cA, voffA); PG8_STAGE(PG8_SA(0, 1), cA + hstep, voffA);
        if (wr == 1) PG8_BAR;
        PG8_WAIT_V(2); PG8_BAR;
        PG8_STAGE(PG8_SB(1, 0), cB + kstep, voffB); PG8_STAGE(PG8_SA(1, 0), cA + kstep, voffA); PG8_STAGE(PG8_SB(1, 1), cB + hstep + kstep, voffB);
        PG8_WAIT_V(6); PG8_BAR;
    } else {
        PG8_STAGE(PG8_SB(0, 0), cB, voffB); PG8_STAGE(PG8_SA(0, 0), cA, voffA); PG8_STAGE(PG8_SB(0, 1), cB + hstep, voffB); PG8_STAGE(PG8_SA(0, 1), cA + hstep, voffA);
        if (wr == 1) PG8_BAR;
        PG8_WAIT_V(4); PG8_BAR;
        PG8_STAGE(PG8_SB(1, 0), cB + kstep, voffB); PG8_STAGE(PG8_SA(1, 0), cA + kstep, voffA); PG8_STAGE(PG8_SB(1, 1), cB + hstep + kstep, voffB);
        PG8_WAIT_V(6); PG8_BAR;
    }
    for (;;) {
        const bool has_next = S.next(ui + 1, nxt);
        const char* nA = has_next ? (const char*)g.A + (size_t)nxt.pm * tstep : cA; const char* nB = has_next ? (const char*)g.Bt + (size_t)nxt.pn * tstep : cB;
        for (int t = 0; t < nt; t += 2) {
            const bool last = (t == nt - 2);
            const char* a1 = cA + (size_t)(t + 1) * kstep;
            const char* a2 = last ? nA : cA + (size_t)(t + 2) * kstep; const char* b2 = last ? nB : cB + (size_t)(t + 2) * kstep;
            const char* a3 = a2 + kstep; const char* b3 = b2 + kstep;
            if (last && has_next) S.a_ready(nxt);
            if constexpr (SP2) {
            PG8_LDB(B0, 0, 0); PG8_LDB(B1, 0, 1); PG8_SCHED; PG8_LDA(At, 0, 0); PG8_STAGE(PG8_SA(1, 1), a1 + hstep, voffA);
            PG8_WAIT_V(8); PG8_WAIT_L(0); PG8_BAR; PG8_MMA(0, 0, At, B0); PG8_MMA(0, 1, At, B1); PG8_BAR; PG8_SCHED;
            PG8_LDA(At, 0, 1); PG8_STAGE(PG8_SB(0, 0), b2, voffB); PG8_STAGE(PG8_SB(0, 1), b2 + hstep, voffB); PG8_STAGE(PG8_SA(0, 0), a2, voffA);
            PG8_WAIT_V(8); PG8_WAIT_L(0); PG8_BAR; PG8_MMA(1, 0, At, B0); PG8_MMA(1, 1, At, B1); PG8_BAR; PG8_SCHED;
            PG8_LDB(B0, 1, 0); PG8_LDB(B1, 1, 1); PG8_SCHED; PG8_LDA(At, 1, 0); PG8_STAGE(PG8_SA(0, 1), a2 + hstep, voffA);
            PG8_WAIT_V(8); PG8_WAIT_L(0); PG8_BAR; PG8_MMA(0, 0, At, B0); PG8_MMA(0, 1, At, B1); PG8_BAR; PG8_SCHED;
            PG8_LDA(At, 1, 1); PG8_STAGE(PG8_SB(1, 0), b3, voffB); PG8_STAGE(PG8_SB(1, 1), b3 + hstep, voffB); PG8_STAGE(PG8_SA(1, 0), a3, voffA);
            PG8_WAIT_V(8); PG8_WAIT_L(0); PG8_BAR; PG8_MMA(1, 0, At, B0); PG8_MMA(1, 1, At, B1); PG8_BAR; PG8_SCHED;
            } else {
            PG8_LDB(B0, 0, 0); PG8_SCHED; PG8_LDA(At, 0, 0); PG8_STAGE(PG8_SA(1, 1), a1 + hstep, voffA);
            PG8_WAIT_L(8); PG8_BAR; PG8_WAIT_L(0); PG8_MMA(0, 0, At, B0); PG8_BAR; PG8_SCHED;
            PG8_LDB(B1, 0, 1); PG8_STAGE(PG8_SB(0, 0), b2, voffB);
            PG8_BAR; PG8_WAIT_L(0); PG8_MMA(0, 1, At, B1); PG8_BAR;
            PG8_LDA(At, 0, 1); PG8_STAGE(PG8_SA(0, 0), a2, voffA);
            PG8_BAR; PG8_WAIT_L(0); PG8_MMA(1, 0, At, B0); PG8_BAR; PG8_SCHED;
            PG8_STAGE(PG8_SB(0, 1), b2 + hstep, voffB);
            PG8_WAIT_V(6); PG8_BAR; PG8_MMA(1, 1, At, B1); PG8_BAR;
            PG8_LDB(B0, 1, 0); PG8_SCHED; PG8_LDA(At, 1, 0); PG8_STAGE(PG8_SA(0, 1), a2 + hstep, voffA);
            PG8_WAIT_L(8); PG8_BAR; PG8_WAIT_L(0); PG8_MMA(0, 0, At, B0); PG8_BAR; PG8_SCHED;
            PG8_LDB(B1, 1, 1); PG8_STAGE(PG8_SB(1, 0), b3, voffB);
            PG8_BAR; PG8_WAIT_L(0); PG8_MMA(0, 1, At, B1); PG8_BAR;
            PG8_LDA(At, 1, 1); PG8_STAGE(PG8_SA(1, 0), a3, voffA);
            PG8_BAR; PG8_WAIT_L(0); PG8_MMA(1, 0, At, B0); PG8_BAR; PG8_SCHED;
            PG8_STAGE(PG8_SB(1, 1), b3 + hstep, voffB);
            PG8_WAIT_V(6); PG8_BAR; PG8_MMA(1, 1, At, B1); PG8_BAR;
            }
        }
        if constexpr (ALIGN_EPI) { if (wr == 0) PG8_BAR; }
        if constexpr (!Epi::AFTER_DRAIN) { E(acc, cur, wr, wc, fr, fq); S.done(cur); }
        if (!has_next) break;
#pragma unroll
        for (int a = 0; a < 2; ++a)
#pragma unroll
            for (int b = 0; b < 2; ++b)
#pragma unroll
                for (int m = 0; m < 4; ++m)
#pragma unroll
                    for (int n = 0; n < 2; ++n) acc[a][b][m][n] = (i32x4){0, 0, 0, 0};
        cur = nxt; cA = nA; cB = nB; ++ui;
        if constexpr (ALIGN_EPI) { if (wr == 1) PG8_BAR; }
    }
    PG8_WAIT_V(0);
    if constexpr (!ALIGN_EPI) { if (wr == 0) PG8_BAR; }
    PG8_BAR;
    if constexpr (Epi::AFTER_DRAIN) { E.fused(acc, cur, wr, wc, fr, fq, lds, wid, lane); S.done(cur); }
#undef PG8_SA
#undef PG8_SB
#undef PG8_STAGE
#undef PG8_LDA
#undef PG8_LDB
#undef PG8_MMA
#undef PG8_WAIT_V
#undef PG8_WAIT_L
#undef PG8_BAR
#undef PG8_SCHED
}
}

#define GAS __attribute__((address_space(1)))
#define LAS __attribute__((address_space(3)))
typedef unsigned short bf16;
typedef unsigned v4u __attribute__((ext_vector_type(4)));
typedef unsigned v2u __attribute__((ext_vector_type(2)));
typedef float f32x4 __attribute__((ext_vector_type(4)));
typedef float f32x2 __attribute__((ext_vector_type(2)));
typedef short bf16x8 __attribute__((ext_vector_type(8)));
typedef GAS unsigned gu32;
#define RLX_AGENT __ATOMIC_RELAXED, __HIP_MEMORY_SCOPE_AGENT
#define LDS_WAIT() asm volatile("s_waitcnt lgkmcnt(0)" ::: "memory")
#define VM_WAIT() asm volatile("s_waitcnt vmcnt(0)" ::: "memory")

#ifndef MK_PER_PHASE
#define MK_PER_PHASE 0
#endif

constexpr int NWAVES = 8, NTHR = 512;
constexpr int BATCH = 2, SEQ = 8192, DM = 4096, MTOK = BATCH * SEQ;
constexpr int NPROJ = 12288, ML_LD = 12304;
constexpr int FF = 11008, F2 = 22016;
constexpr float EPS = 1e-6f;
constexpr int NPHASE = 28;

constexpr size_t MiB = 1u << 20;
constexpr size_t WS_CTL = 0, CTL_ZERO_BYTES = 1 * MiB;
constexpr size_t WS_WIN = 1 * MiB, WS_WG = 97 * MiB, WS_WAO = 98 * MiB, WS_WQKV = 130 * MiB, WS_WBO = 226 * MiB;
constexpr size_t WS_WUP0 = 258 * MiB, WS_WUP1 = 430 * MiB, WS_WDN0 = 602 * MiB, WS_WDN1 = 688 * MiB;
constexpr size_t WS_X = 774 * MiB, WS_XN = 1030 * MiB, WS_HG = 1158 * MiB;
constexpr size_t WS_SS = 1286 * MiB;
constexpr size_t WS_SA = 1290 * MiB;
constexpr size_t WS_FA = 1287 * MiB, WS_FG = 1288 * MiB, WS_FF = 1289 * MiB, WS_SEL = 1291 * MiB, WS_ML = 1293 * MiB;
constexpr size_t WS_BIG = 1309 * MiB;
constexpr size_t WS_GATES = WS_BIG + 912 * MiB;
constexpr size_t WS_PROJ = WS_BIG, WS_UT = WS_BIG + 384 * MiB, WS_ST = WS_BIG + 648 * MiB;
constexpr size_t WS_HC = WS_BIG, WS_ACT = WS_BIG + 688 * MiB;
constexpr size_t WS_PART = WS_BIG + 384 * MiB;
constexpr size_t WS_KM = WS_BIG + 896 * MiB;
constexpr size_t WS_END = WS_BIG + 1032 * MiB;

constexpr int CW_BAR = 4096;
constexpr int CW_WQ = 16384;
constexpr int CW_WMAX_AO = 65536, CW_WMAX_QKV = 69632, CW_WMAX_BO = 81920, CW_WMAX_UP0 = 90112, CW_WMAX_UP1 = 114688, CW_WMAX_DN0 = 139264, CW_WMAX_DN1 = 143360, CW_WMAX_INO = 147456;
constexpr int LDS_BYTES = 155648;
constexpr int MISC_OFF = 155648 - 256;

__device__ __forceinline__ unsigned f2bf(float f) { unsigned u = __builtin_bit_cast(unsigned, f); return (u + 0x7fffu + ((u >> 16) & 1u)) >> 16; }
__device__ __forceinline__ unsigned pk2(float lo, float hi) { return f2bf(lo) | (f2bf(hi) << 16); }
__device__ __forceinline__ float bflo(unsigned x) { return __uint_as_float(x << 16); }
__device__ __forceinline__ float bfhi(unsigned x) { return __uint_as_float(x & 0xffff0000u); }
__device__ __forceinline__ float bf2f(bf16 x) { return __uint_as_float(((unsigned)x) << 16); }
__device__ __forceinline__ float wave_sum(float v) {
#pragma unroll
    for (int o = 1; o < 64; o <<= 1) v += __shfl_xor(v, o);
    return v;
}
__device__ __forceinline__ f32x4 mfma16(bf16x8 a, bf16x8 b, f32x4 c) { return __builtin_amdgcn_mfma_f32_16x16x32_bf16(a, b, c, 0, 0, 0); }
__device__ __forceinline__ int fresh_lane() { int l; asm volatile("v_mbcnt_lo_u32_b32 %0, -1, 0\n\tv_mbcnt_hi_u32_b32 %0, -1, %0" : "=v"(l)); return l; }
template <int CTRL> __device__ __forceinline__ float dppf(float v) { return __builtin_bit_cast(float, __builtin_amdgcn_update_dpp(0, __builtin_bit_cast(int, v), CTRL, 0xF, 0xF, false)); }

#define XB_TMO      128
#define XB_XCNT(j)  (256  + 64 * (j))
#define XB_XSUB(j)  (1280 + 64 * (j))
#define XB_XGEN(j)  (2304 + 64 * (j))
#define XB_TOP      3328
#define XB_TOPGEN   3392
#define XCD_BAR_WORDS 3456
#define XB_SPIN_CAP (1u << 18)
__device__ __forceinline__ unsigned xb_ld(unsigned* p)              { return __hip_atomic_load(p, __ATOMIC_RELAXED, __HIP_MEMORY_SCOPE_AGENT); }
__device__ __forceinline__ unsigned xb_add(unsigned* p, unsigned v) { return __hip_atomic_fetch_add(p, v, __ATOMIC_RELAXED, __HIP_MEMORY_SCOPE_AGENT); }
__device__ __forceinline__ unsigned xb_xcc_id() { return (unsigned)__builtin_amdgcn_s_getreg((3 << 11) | 20) & 0xFu; }
#define XB_SPIN(cond, bar) do { unsigned _sp = 0; while (cond) { __builtin_amdgcn_s_sleep(1); \
    if ((++_sp & 255u) == 0u) { if (xb_ld(&(bar)[XB_TMO])) break; if (_sp > XB_SPIN_CAP) { atomicAdd(&(bar)[XB_TMO], 1u); break; } } } } while (0)
struct XcdBarrier { unsigned* bar; unsigned x; volatile LAS unsigned* st; };
__device__ __forceinline__ XcdBarrier xcd_barrier_post(unsigned* bar, volatile LAS unsigned* st) {
    XcdBarrier b; b.bar = bar; b.x = xb_xcc_id(); b.st = st;
    if (threadIdx.x == 0) (void)xb_add(&bar[XB_XCNT(b.x)], 1u);
    return b;
}
__device__ __forceinline__ void xcd_barrier_complete(unsigned* bar, unsigned x, unsigned& nloc, unsigned& nx) {
    const unsigned G = gridDim.x * gridDim.y * gridDim.z;
    unsigned sum, cnt, mine, sp = 0u;
    for (;;) {
        sum = 0u; cnt = 0u; mine = 0u;
#pragma unroll
        for (unsigned j = 0; j < 16; ++j) { const unsigned c = xb_ld(&bar[XB_XCNT(j)]); sum += c; cnt += (c > 0u) ? 1u : 0u; mine = (j == x) ? c : mine; }
        if (sum == G) break;
        __builtin_amdgcn_s_sleep(1);
        if ((++sp & 255u) == 0u) { if (xb_ld(&bar[XB_TMO])) break; if (sp > XB_SPIN_CAP) { atomicAdd(&bar[XB_TMO], 1u); break; } }
    }
    nloc = mine > 0u ? mine : 1u; nx = cnt > 0u ? cnt : 1u;
}
__device__ __forceinline__ void xcd_barrier(const XcdBarrier& b) {
    asm volatile("s_waitcnt vmcnt(0)" ::: "memory");
    __syncthreads();
    if (threadIdx.x == 0) {
        unsigned* bar = b.bar;
        __builtin_amdgcn_s_waitcnt(0);
        unsigned nloc = b.st[0], nx = b.st[1];
        if (nloc == 0u) { xcd_barrier_complete(bar, b.x, nloc, nx); b.st[0] = nloc; b.st[1] = nx; }
        const unsigned old = xb_add(&bar[XB_XSUB(b.x)], 1u);
        const unsigned gen = old / nloc;
        if (old + 1u == (gen + 1u) * nloc) {
            __builtin_amdgcn_fence(__ATOMIC_RELEASE, "agent");
            asm volatile("s_waitcnt vmcnt(0)" ::: "memory");
            const unsigned og = xb_add(&bar[XB_TOP], 1u);
            const unsigned tg = og / nx;
            if (og + 1u == (tg + 1u) * nx) xb_add(&bar[XB_TOPGEN], 1u);
            else XB_SPIN(xb_ld(&bar[XB_TOPGEN]) == tg, bar);
            __builtin_amdgcn_fence(__ATOMIC_ACQUIRE, "agent");
            xb_add(&bar[XB_XGEN(b.x)], 1u);
            asm volatile("s_waitcnt vmcnt(0)" ::: "memory");
        } else {
            XB_SPIN(xb_ld(&bar[XB_XGEN(b.x)]) == gen, bar);
            __builtin_amdgcn_fence(__ATOMIC_ACQUIRE, "agent");
            asm volatile("s_waitcnt vmcnt(0)" ::: "memory");
        }
    }
    __syncthreads();
}

struct Ctx {
    LAS unsigned char* lds;
    int tid, lane, wave, G, bid;
    const float *x, *norm_mix, *norm_ffn, *a_w_in, *a_gate_bias, *a_head_norm, *a_w_out, *b_w_qkv, *b_w_out, *ffn_w_up, *ffn_conv_w, *ffn_conv_b, *ffn_w_down, *final_norm;
    float* out;
    unsigned* ctl;
    bf16 *Win, *Wg, *Wao, *Wqkv, *Wbo, *Wup0, *Wup1, *Wdn0, *Wdn1;
    float* X; bf16 *XN, *HG;
    float *GATES, *FA, *FG, *FFv, *KM, *ML; int* SEL;
    bf16 *PROJ, *UT, *ST, *HC, *ACT, *PART;
    float *HALO, *HEAD, *SS; bf16* Xb;
    signed char *A8, *Wao8, *Wqkv8, *Wbo8, *Wup08, *Wup18, *Wdn08, *Wdn18, *ACT8, *Win8, *XN8; float* SA;
};

template <bool UPPERM = false>
__device__ __forceinline__ void transpose_item(const float* W, int ldw, int K, int nblk, bf16* WT, LAS float* scr, int item, int lane, const float* gk = nullptr) {
    const int kb = item / nblk, nb = item % nblk, k0 = 64 * kb, n0 = 64 * nb;
    const int n0o = !UPPERM ? n0 : (n0 < FF ? (n0 >> 7) * 256 + (n0 & 127) : ((n0 - FF) >> 7) * 256 + 128 + ((n0 - FF) & 127));
    const float* src = W + (size_t)k0 * ldw + n0 + lane;
    { float tmp[64];
#pragma unroll
      for (int i = 0; i < 64; ++i) tmp[i] = src[(size_t)i * ldw];
#pragma unroll
      for (int i = 0; i < 64; ++i) scr[i * 65 + lane] = tmp[i]; }
    LDS_WAIT(); asm volatile("" ::: "memory");
    const int c = lane & 7;
    f32x4 g0 = {1.f, 1.f, 1.f, 1.f}, g1 = g0;
    if (gk) { g0 = *(const f32x4*)(gk + k0 + 8 * c); g1 = *(const f32x4*)(gk + k0 + 8 * c + 4); }
#pragma unroll
    for (int j = 0; j < 8; ++j) { const int n = (lane >> 3) + 8 * j; const LAS float* s = scr + (8 * c) * 65 + n;
        v4u o; o.x = pk2(s[0 * 65] * g0.x, s[1 * 65] * g0.y); o.y = pk2(s[2 * 65] * g0.z, s[3 * 65] * g0.w); o.z = pk2(s[4 * 65] * g1.x, s[5 * 65] * g1.y); o.w = pk2(s[6 * 65] * g1.z, s[7 * 65] * g1.w);
        *(v4u*)(WT + (size_t)(n0o + n) * K + k0 + 8 * c) = o; }
    LDS_WAIT(); asm volatile("" ::: "memory");
}
__device__ __forceinline__ void rms_row_bf16(const float* xrow, const float* g, bf16* orow, int lane) {
    const f32x4* xr = (const f32x4*)xrow + lane; const f32x4* gr = (const f32x4*)g + lane;
    f32x4 v[16]; float s = 0.f;
#pragma unroll
    for (int j = 0; j < 16; ++j) { v[j] = xr[64 * j]; s += (v[j].x * v[j].x + v[j].y * v[j].y) + (v[j].z * v[j].z + v[j].w * v[j].w); }
    const float rstd = 1.0f / sqrtf(wave_sum(s) * (1.0f / DM) + EPS);
    v2u* o8 = (v2u*)orow + lane;
#pragma unroll
    for (int j = 0; j < 16; ++j) { const f32x4 gv = gr[64 * j]; v2u o; o.x = pk2(v[j].x * rstd * gv.x, v[j].y * rstd * gv.y); o.y = pk2(v[j].z * rstd * gv.z, v[j].w * rstd * gv.w); o8[64 * j] = o; }
}
__device__ __forceinline__ void rms_row_f32(const float* xrow, const float* g, float* orow, int lane) {
    const f32x4* xr = (const f32x4*)xrow + lane; const f32x4* gr = (const f32x4*)g + lane;
    f32x4 v[16]; float s = 0.f;
#pragma unroll
    for (int j = 0; j < 16; ++j) { v[j] = xr[64 * j]; s += (v[j].x * v[j].x + v[j].y * v[j].y) + (v[j].z * v[j].z + v[j].w * v[j].w); }
    const float rstd = 1.0f / sqrtf(wave_sum(s) * (1.0f / DM) + EPS);
    f32x4* o = (f32x4*)orow + lane;
#pragma unroll
    for (int j = 0; j < 16; ++j) { const f32x4 gv = gr[64 * j]; o[64 * j] = v[j] * rstd * gv; }
}
__device__ __forceinline__ void rms_row_bf16_to_f32(const bf16* xrow, const float* g, float* orow, int lane) {
    const v4u* xr = (const v4u*)xrow + lane; const f32x4* gr = (const f32x4*)g + 2 * lane;
    float v[8][8]; float s = 0.f;
#pragma unroll
    for (int j = 0; j < 8; ++j) { const v4u x = xr[64 * j]; v[j][0] = bflo(x.x); v[j][1] = bfhi(x.x); v[j][2] = bflo(x.y); v[j][3] = bfhi(x.y); v[j][4] = bflo(x.z); v[j][5] = bfhi(x.z); v[j][6] = bflo(x.w); v[j][7] = bfhi(x.w);
#pragma unroll
        for (int k = 0; k < 8; ++k) s += v[j][k] * v[j][k]; }
    const float rstd = 1.0f / sqrtf(wave_sum(s) * (1.0f / DM) + EPS);
    f32x4* o = (f32x4*)orow + 2 * lane;
#pragma unroll
    for (int j = 0; j < 8; ++j) { const f32x4 g0 = gr[128 * j], g1 = gr[128 * j + 1];
        o[128 * j] = (f32x4){v[j][0] * rstd * g0.x, v[j][1] * rstd * g0.y, v[j][2] * rstd * g0.z, v[j][3] * rstd * g0.w};
        o[128 * j + 1] = (f32x4){v[j][4] * rstd * g1.x, v[j][5] * rstd * g1.y, v[j][6] * rstd * g1.z, v[j][7] * rstd * g1.w}; }
}
__device__ __forceinline__ void rms_row_bf16_i8(const float* xrow, const float* g, bf16* orow, signed char* qrow, float* sa, int lane) {
    const f32x4* xr = (const f32x4*)xrow + lane; const f32x4* gr = (const f32x4*)g + lane;
    f32x4 v[16]; float s = 0.f;
#pragma unroll
    for (int j = 0; j < 16; ++j) { v[j] = xr[64 * j]; s += (v[j].x * v[j].x + v[j].y * v[j].y) + (v[j].z * v[j].z + v[j].w * v[j].w); }
    const float rstd = 1.0f / sqrtf(wave_sum(s) * (1.0f / DM) + EPS);
    float mx = 0.f;
#pragma unroll
    for (int j = 0; j < 16; ++j) { v[j] = v[j] * rstd * gr[64 * j]; mx = fmaxf(mx, fmaxf(fmaxf(fabsf(v[j].x), fabsf(v[j].y)), fmaxf(fabsf(v[j].z), fabsf(v[j].w)))); }
#pragma unroll
    for (int o = 1; o < 64; o <<= 1) mx = fmaxf(mx, __shfl_xor(mx, o));
    mx = fmaxf(mx, 1e-30f); const float inv = 127.0f / mx;
    if (lane == 0) *sa = mx * (1.0f / 127.0f);
    v2u* o8 = (v2u*)orow + lane; unsigned* q4 = (unsigned*)qrow + lane;
#pragma unroll
    for (int j = 0; j < 16; ++j) { v2u o; o.x = pk2(v[j].x, v[j].y); o.y = pk2(v[j].z, v[j].w); o8[64 * j] = o;
        const int a0 = (int)__builtin_rintf(v[j].x * inv), a1 = (int)__builtin_rintf(v[j].y * inv), a2 = (int)__builtin_rintf(v[j].z * inv), a3 = (int)__builtin_rintf(v[j].w * inv);
        q4[64 * j] = (unsigned)(a0 & 255) | ((unsigned)(a1 & 255) << 8) | ((unsigned)(a2 & 255) << 16) | ((unsigned)(a3 & 255) << 24); }
}
__device__ __forceinline__ void phase_norm_bf16(const Ctx& C0, const float* src, const float* g, bf16* dst) {
    Ctx C = C0; C.lane = fresh_lane(); C.tid = C.wave * 64 + C.lane;
    const int gw = C.bid * NWAVES + C.wave, NGW = C.G * NWAVES;
    for (int m = gw; m < MTOK; m += NGW) rms_row_bf16_i8(src + (size_t)m * DM, g, dst + (size_t)m * DM, C.XN8 + (size_t)m * DM, C.SA + m, C.lane);
}
template <bool UPPERM = false>
__device__ __forceinline__ void wmax_item(const float* W, int ldw, int nblk, unsigned* wmax, int item, int lane, const float* gk) {
    const int kb = item / nblk, nb = item % nblk, k0 = 64 * kb, n0 = 64 * nb;
    const int n0o = !UPPERM ? n0 : (n0 < FF ? (n0 >> 7) * 256 + (n0 & 127) : ((n0 - FF) >> 7) * 256 + 128 + ((n0 - FF) & 127));
    const float* src = W + (size_t)k0 * ldw + n0 + lane; float m = 0.f;
    { float tmp[64];
#pragma unroll
      for (int i = 0; i < 64; ++i) tmp[i] = src[(size_t)i * ldw];
#pragma unroll
      for (int i = 0; i < 64; ++i) m = fmaxf(m, fabsf(tmp[i] * (gk ? gk[k0 + i] : 1.0f))); }
    atomicMax(wmax + n0o + lane, __float_as_uint(m));
}
__device__ __forceinline__ unsigned pack4_i8(float a, float b, float c, float d) {
    const int a0 = (int)__builtin_rintf(a), a1 = (int)__builtin_rintf(b), a2 = (int)__builtin_rintf(c), a3 = (int)__builtin_rintf(d);
    return (unsigned)(a0 & 255) | ((unsigned)(a1 & 255) << 8) | ((unsigned)(a2 & 255) << 16) | ((unsigned)(a3 & 255) << 24);
}
template <bool UPPERM = false>
__device__ __forceinline__ void quant_item(const float* W, int ldw, int K, int nblk, signed char* WT, const unsigned* wmax, int item, int lane, const float* gk) {
    const int kb = item / nblk, nb = item % nblk, k0 = 128 * kb, n0 = 64 * nb;
    const int n0o = !UPPERM ? n0 : (n0 < FF ? (n0 >> 7) * 256 + (n0 & 127) : ((n0 - FF) >> 7) * 256 + 128 + ((n0 - FF) & 127));
    const float inv = 127.0f / fmaxf(__uint_as_float(wmax[n0o + lane]), 1e-30f);
    const float* src = W + (size_t)k0 * ldw + n0;
    signed char* dst = WT + (size_t)(n0o + lane) * K + k0;
#pragma unroll
    for (int hb = 0; hb < 2; ++hb) { float v[64];
#pragma unroll
        for (int i = 0; i < 64; ++i) v[i] = (src + (size_t)(64 * hb + i) * ldw)[lane];
#pragma unroll
        for (int i = 0; i < 64; ++i) v[i] *= (gk ? gk[k0 + 64 * hb + i] : 1.0f) * inv;
#pragma unroll
        for (int c = 0; c < 4; ++c) { v4u w; w.x = pack4_i8(v[16 * c], v[16 * c + 1], v[16 * c + 2], v[16 * c + 3]); w.y = pack4_i8(v[16 * c + 4], v[16 * c + 5], v[16 * c + 6], v[16 * c + 7]);
            w.z = pack4_i8(v[16 * c + 8], v[16 * c + 9], v[16 * c + 10], v[16 * c + 11]); w.w = pack4_i8(v[16 * c + 12], v[16 * c + 13], v[16 * c + 14], v[16 * c + 15]);
            *(v4u*)(dst + 64 * hb + 16 * c) = w; } }
}
__device__ __forceinline__ void fwht_xlane(float& x, int m, int lane) { const float p = __shfl_xor(x, m); x = (lane & m) ? (p - x) : (x + p); }
template <int M> __device__ __forceinline__ float dpp_xor(float x, int lane) {
    if (M == 1) return dppf<0xB1>(x);
    if (M == 2) return dppf<0x4E>(x);
    if (M == 8) return dppf<0x128>(x);
    const float dn4 = dppf<0x124>(x), up4 = dppf<0x12C>(x);
    return (lane & 4) ? dn4 : up4;
}
template <int M> __device__ __forceinline__ void fwht_dpp(float& x, int lane, float sgn) { x = fmaf(x, sgn, dpp_xor<M>(x, lane)); }
__device__ __forceinline__ void dn_load_rotate(const float* W, int item, int lane, float (&v)[128], int& kb, int& n0) {
    kb = item >> 6; n0 = 64 * (item & 63);
    const float* src = W + (size_t)(128 * kb) * DM + n0;
#pragma unroll
    for (int hb = 0; hb < 2; ++hb)
#pragma unroll
        for (int i = 0; i < 64; ++i) v[64 * hb + i] = (src + (size_t)(64 * hb + i) * DM)[lane];
    __builtin_amdgcn_sched_barrier(0);
#pragma unroll
    for (int st = 1; st < 128; st <<= 1)
#pragma unroll
        for (int i = 0; i < 128; ++i) if (!(i & st)) { const float a = v[i], b = v[i | st]; v[i] = a + b; v[i | st] = a - b; }
#pragma unroll
    for (int q = 0; q < 128; ++q) v[q] *= (1.0f / 128.0f);
    __builtin_amdgcn_sched_barrier(0);
}
__device__ __forceinline__ void dn_wmax_item(const float* W, unsigned* wmax, int item, int lane) {
    float v[128]; int kb, n0; dn_load_rotate(W, item, lane, v, kb, n0);
    float m = 0.f;
#pragma unroll
    for (int q = 0; q < 128; ++q) m = fmaxf(m, fabsf(v[q]));
    { int la = lane; asm volatile("" : "+v"(la)); atomicMax(wmax + n0 + la, __float_as_uint(m)); }
}
__device__ __forceinline__ void dn_quant_item(const float* W, signed char* WT, const unsigned* wmax, int item, int lane) {
    float v[128]; int kb, n0; dn_load_rotate(W, item, lane, v, kb, n0);
    const float inv = 127.0f / fmaxf(__uint_as_float(wmax[n0 + lane]), 1e-30f);
    signed char* dst = WT + (size_t)(n0 + lane) * FF + 128 * kb;
#pragma unroll
    for (int c = 0; c < 8; ++c) { v4u w; w.x = pack4_i8(v[16 * c] * inv, v[16 * c + 1] * inv, v[16 * c + 2] * inv, v[16 * c + 3] * inv); w.y = pack4_i8(v[16 * c + 4] * inv, v[16 * c + 5] * inv, v[16 * c + 6] * inv, v[16 * c + 7] * inv);
        w.z = pack4_i8(v[16 * c + 8] * inv, v[16 * c + 9] * inv, v[16 * c + 10] * inv, v[16 * c + 11] * inv); w.w = pack4_i8(v[16 * c + 12] * inv, v[16 * c + 13] * inv, v[16 * c + 14] * inv, v[16 * c + 15] * inv);
        *(v4u*)(dst + 16 * c) = w; }
}
__device__ __forceinline__ void phase_quant_act(const Ctx& C0) {
    Ctx C = C0; C.lane = fresh_lane(); C.tid = C.wave * 64 + C.lane;
    const int l = C.lane, w = C.wave, pr = w >> 1, hf = w & 1;
    const float sg1 = (l & 1) ? -1.f : 1.f, sg2 = (l & 2) ? -1.f : 1.f, sg4 = (l & 4) ? -1.f : 1.f, sg8 = (l & 8) ? -1.f : 1.f;
    LAS float* mxs = (LAS float*)C.lds;
    int par = 0;
    for (int m0 = C.bid * 4; m0 < MTOK; m0 += C.G * 4, par ^= 1) {
        const int m = m0 + pr;
        const v4u* xr = (const v4u*)(C.ACT + (size_t)m * FF) + l;
        v4u x[11];
#pragma unroll
        for (int t = 0; t < 11; ++t) { const int c = 64 * (11 * hf + t) + l; x[t] = (c < FF / 8) ? xr[64 * (11 * hf + t)] : (v4u){0u, 0u, 0u, 0u}; }
        float v[11][8]; float mx = 0.f;
#pragma unroll
        for (int t = 0; t < 11; ++t) {
            v[t][0] = bflo(x[t].x); v[t][1] = bfhi(x[t].x); v[t][2] = bflo(x[t].y); v[t][3] = bfhi(x[t].y); v[t][4] = bflo(x[t].z); v[t][5] = bfhi(x[t].z); v[t][6] = bflo(x[t].w); v[t][7] = bfhi(x[t].w);
#pragma unroll
            for (int st = 1; st < 8; st <<= 1)
#pragma unroll
                for (int i = 0; i < 8; ++i) if (!(i & st)) { const float a = v[t][i], b = v[t][i | st]; v[t][i] = a + b; v[t][i | st] = a - b; }
#pragma unroll
            for (int i = 0; i < 8; ++i) { fwht_dpp<1>(v[t][i], l, sg1); fwht_dpp<2>(v[t][i], l, sg2); fwht_dpp<4>(v[t][i], l, sg4); fwht_dpp<8>(v[t][i], l, sg8); mx = fmaxf(mx, fabsf(v[t][i])); }
        }
#pragma unroll
        for (int o = 1; o < 64; o <<= 1) mx = fmaxf(mx, __shfl_xor(mx, o));
        if (l == 0) mxs[par * 8 + w] = mx;
        __syncthreads();
        mx = fmaxf(fmaxf(mxs[par * 8 + (w & 6)], mxs[par * 8 + (w | 1)]), 1e-30f);
        const float inv = 127.0f / mx;
        if (l == 0 && hf == 0) C.SA[m] = mx * (1.0f / 127.0f);
        v2u* o8 = (v2u*)(C.ACT8 + (size_t)m * FF) + l;
#pragma unroll
        for (int t = 0; t < 11; ++t) { const int tt = 11 * hf + t;
            v2u o; o.x = pack4_i8(v[t][0] * inv, v[t][1] * inv, v[t][2] * inv, v[t][3] * inv); o.y = pack4_i8(v[t][4] * inv, v[t][5] * inv, v[t][6] * inv, v[t][7] * inv);
            if (64 * tt + l < FF / 8) o8[64 * tt] = o; }
    }
}
__device__ __forceinline__ void phase_quant_weights(const Ctx& C0) {
    Ctx C = C0; C.lane = fresh_lane(); C.tid = C.wave * 64 + C.lane;
    const int gw = C.bid * NWAVES + C.wave, NGW = C.G * NWAVES;
    constexpr int J_DN = 86 * 64;
    for (int ir = gw; ir < 2 * J_DN; ir += NGW) { const int it = 2 * J_DN - 1 - ir;
        if (it < J_DN) dn_quant_item(C.ffn_w_down, C.Wdn08, C.ctl + CW_WMAX_DN0, it, C.lane);
        else dn_quant_item(C.ffn_w_down + (size_t)FF * DM, C.Wdn18, C.ctl + CW_WMAX_DN1, it - J_DN, C.lane);
    }
}
template <bool NORM>
__device__ __forceinline__ void phase_quant_rows(const Ctx& C0, const bf16* src, signed char* dst, float* SA) {
    Ctx C = C0; C.lane = fresh_lane(); C.tid = C.wave * 64 + C.lane;
    const int gw = C.bid * NWAVES + C.wave, NGW = C.G * NWAVES, l = C.lane;
    for (int m = gw; m < MTOK; m += NGW) {
        const v4u* xr = (const v4u*)(src + (size_t)m * DM) + l;
        v4u x[8]; float mx = 0.f, ss = 0.f;
#pragma unroll
        for (int j = 0; j < 8; ++j) x[j] = xr[64 * j];
#pragma unroll
        for (int j = 0; j < 8; ++j) {
            const float e0 = bflo(x[j].x), e1 = bfhi(x[j].x), e2 = bflo(x[j].y), e3 = bfhi(x[j].y), e4 = bflo(x[j].z), e5 = bfhi(x[j].z), e6 = bflo(x[j].w), e7 = bfhi(x[j].w);
            mx = fmaxf(mx, fmaxf(fmaxf(fabsf(e0), fabsf(e1)), fmaxf(fabsf(e2), fabsf(e3))));
            mx = fmaxf(mx, fmaxf(fmaxf(fabsf(e4), fabsf(e5)), fmaxf(fabsf(e6), fabsf(e7))));
            if (NORM) ss += ((e0 * e0 + e1 * e1) + (e2 * e2 + e3 * e3)) + ((e4 * e4 + e5 * e5) + (e6 * e6 + e7 * e7)); }
#pragma unroll
        for (int o = 1; o < 64; o <<= 1) mx = fmaxf(mx, __shfl_xor(mx, o));
        if (NORM) ss = wave_sum(ss);
        mx = fmaxf(mx, 1e-30f);
        const float inv = 127.0f / mx;
        if (l == 0) SA[m] = NORM ? mx * (1.0f / 127.0f) / sqrtf(ss * (1.0f / DM) + EPS) : mx * (1.0f / 127.0f);
        v2u* o8 = (v2u*)(dst + (size_t)m * DM) + l;
#pragma unroll
        for (int j = 0; j < 8; ++j) {
            const int a0 = (int)__builtin_rintf(bflo(x[j].x) * inv), a1 = (int)__builtin_rintf(bfhi(x[j].x) * inv), a2 = (int)__builtin_rintf(bflo(x[j].y) * inv), a3 = (int)__builtin_rintf(bfhi(x[j].y) * inv);
            const int a4 = (int)__builtin_rintf(bflo(x[j].z) * inv), a5 = (int)__builtin_rintf(bfhi(x[j].z) * inv), a6 = (int)__builtin_rintf(bflo(x[j].w) * inv), a7 = (int)__builtin_rintf(bfhi(x[j].w) * inv);
            v2u o; o.x = (unsigned)(a0 & 255) | ((unsigned)(a1 & 255) << 8) | ((unsigned)(a2 & 255) << 16) | ((unsigned)(a3 & 255) << 24);
            o.y = (unsigned)(a4 & 255) | ((unsigned)(a5 & 255) << 8) | ((unsigned)(a6 & 255) << 16) | ((unsigned)(a7 & 255) << 24);
            o8[64 * j] = o; }
    }
}
template <bool UPPERM>
__device__ __forceinline__ void colblock_item(const Ctx& C, const float* W, int ldw, signed char* WT, unsigned* wmax_out, int blk) {
    const int l = C.lane, w = C.wave, col = l & 31, par = l >> 5;
    const int n0 = 32 * blk;
    const int n0o = !UPPERM ? n0 : (n0 < FF ? (n0 >> 7) * 256 + (n0 & 127) : ((n0 - FF) >> 7) * 256 + 128 + ((n0 - FF) & 127));
    LAS float* cm = (LAS float*)(C.lds + 135168);
    const LAS float* gs = (const LAS float*)(C.lds + 136192) + par * 2048 + 256 * w;
    const float* src = W + (size_t)(512 * w) * ldw + n0;
    const size_t loff = (size_t)par * ldw + col;
    float m = 0.f;
#pragma unroll 1
    for (int b = 0; b < 4; ++b) {
        float v[64];
#pragma unroll
        for (int i = 0; i < 64; ++i) v[i] = (src + (size_t)(128 * b + 2 * i) * ldw)[loff];
#pragma unroll
        for (int i = 0; i < 64; i += 4) { const f32x4 g4 = *(const LAS f32x4*)(gs + 64 * b + i);
            m = fmaxf(m, fmaxf(fmaxf(fabsf(v[i] * g4.x), fabsf(v[i + 1] * g4.y)), fmaxf(fabsf(v[i + 2] * g4.z), fabsf(v[i + 3] * g4.w)))); }
    }
    m = fmaxf(m, __shfl_xor(m, 32));
    __syncthreads();
    if (par == 0) cm[w * 32 + col] = m;
    __syncthreads();
    float cmx = cm[col];
#pragma unroll
    for (int q = 1; q < 8; ++q) cmx = fmaxf(cmx, cm[q * 32 + col]);
    if (w == 0 && par == 0) wmax_out[n0o + col] = __float_as_uint(cmx);
    const float inv = 127.0f / fmaxf(cmx, 1e-30f);
    signed char* dst = WT + (size_t)(n0o + col) * DM + 512 * w;
#pragma unroll 1
    for (int b = 0; b < 4; ++b) {
        float v[64];
#pragma unroll
        for (int i = 0; i < 64; ++i) v[i] = (src + (size_t)(128 * b + 2 * i) * ldw)[loff];
        unsigned mb[16];
#pragma unroll
        for (int d = 0; d < 16; ++d) { const f32x4 g4 = *(const LAS f32x4*)(gs + 64 * b + 4 * d);
            mb[d] = pack4_i8(v[4 * d] * g4.x * inv, v[4 * d + 1] * g4.y * inv, v[4 * d + 2] * g4.z * inv, v[4 * d + 3] * g4.w * inv); }
#pragma unroll
        for (int cp = 0; cp < 4; ++cp) {
            const int xm = 2 * cp + par, xo = 2 * cp + 1 - par;
            const unsigned s0 = par ? mb[4 * cp] : mb[4 * cp + 2], s1 = par ? mb[4 * cp + 1] : mb[4 * cp + 3];
            const unsigned k0 = par ? mb[4 * cp + 2] : mb[4 * cp], k1 = par ? mb[4 * cp + 3] : mb[4 * cp + 1];
            const unsigned r0 = (unsigned)__shfl_xor((int)s0, 32), r1 = (unsigned)__shfl_xor((int)s1, 32);
            const unsigned e0 = par ? r0 : k0, e1 = par ? r1 : k1, o0 = par ? k0 : r0, o1 = par ? k1 : r1;
            v4u ov; ov.x = __builtin_amdgcn_perm(o0, e0, 0x05010400u); ov.y = __builtin_amdgcn_perm(o0, e0, 0x07030602u);
            ov.z = __builtin_amdgcn_perm(o1, e1, 0x05010400u); ov.w = __builtin_amdgcn_perm(o1, e1, 0x07030602u);
            (void)xo; *(v4u*)(dst + 128 * b + 16 * xm) = ov;
        }
    }
}
__device__ __forceinline__ void colblock_gains(const Ctx& C, const float* g) {
    LAS float* gs = (LAS float*)(C.lds + 136192);
    __syncthreads();
    for (int i = C.tid; i < DM; i += NTHR) gs[(i & 1) * 2048 + (i >> 1)] = g ? g[i] : 1.0f;
    __syncthreads();
}
constexpr int CW_GRP = 20480;
__device__ __forceinline__ void phase_prologue(const Ctx& C0) {
    Ctx C = C0; C.lane = fresh_lane(); C.tid = C.wave * 64 + C.lane;
    LAS float* scr = (LAS float*)(C.lds + C.wave * 16896);
    const int gw = C.bid * NWAVES + C.wave, NGW = C.G * NWAVES;
    constexpr int I_DN = 86 * 64, I_INB = 64 * 128;
    constexpr int NITEMS = I_INB + 2 * I_DN;
    (void)NITEMS;
    for (int it = gw; it < I_INB; it += NGW) transpose_item(C.a_w_in, ML_LD, DM, 128, C.Win, scr, it, C.lane);
    {
        typedef float v2f __attribute__((ext_vector_type(2)));
        constexpr int P_UP = F2 / 128, P_QKV = NPROJ / 128, P_SQ = DM / 128, NP = 2 * P_UP + P_QKV + 3 * P_SQ;
        const int ngroups = C.G >> 3, g = C.bid % ngroups, member = C.bid / ngroups;
        if (member < 8 && ngroups <= 64) {
            const int l = C.lane, w = C.wave, tid = C.tid;
            unsigned* gcnt = C.ctl + CW_GRP + 64 * g;
            LAS float* pm = (LAS float*)(C.lds + 135168);
            LAS float* gtab = (LAS float*)(C.lds + 143360);
            __syncthreads();
            { const int i = tid; gtab[i] = C.norm_ffn[512 * member + i]; gtab[512 + i] = C.norm_ffn[DM + 512 * member + i]; gtab[1024 + i] = C.norm_mix[DM + 512 * member + i]; gtab[1536 + i] = 1.0f; }
            __syncthreads();
            v2f v[64];
#pragma unroll
            for (int j = 0; j < 64; ++j) v[j] = (v2f){0.f, 0.f};
            unsigned n = 0;
            for (int it = g - ngroups; it < NP; it += ngroups) {
                const bool have = it >= 0;
                int r = have ? it : 0, mat;
                if (r < P_UP) mat = 0; else if ((r -= P_UP) < P_UP) mat = 1; else if ((r -= P_UP) < P_QKV) mat = 2; else if ((r -= P_QKV) < P_SQ) mat = 3; else if ((r -= P_SQ) < P_SQ) mat = 4; else { r -= P_SQ; mat = 5; }
                signed char* WT; unsigned* wm;
                if (mat == 0) { WT = C.Wup08; wm = C.ctl + CW_WMAX_UP0; } else if (mat == 1) { WT = C.Wup18; wm = C.ctl + CW_WMAX_UP1; } else if (mat == 2) { WT = C.Wqkv8; wm = C.ctl + CW_WMAX_QKV; }
                else if (mat == 3) { WT = C.Wao8; wm = C.ctl + CW_WMAX_AO; } else if (mat == 4) { WT = C.Wbo8; wm = C.ctl + CW_WMAX_BO; } else { WT = C.Win8; wm = C.ctl + CW_WMAX_INO; }
                const int n0 = 128 * r, n0o = mat >= 2 ? n0 : (n0 < FF ? (n0 >> 7) * 256 : ((n0 - FF) >> 7) * 256 + 128);
                unsigned pc0[32], pc1[32]; float m0 = 0.f, m1 = 0.f;
                if (have) {
                    const LAS float* gs = gtab + 512 * (mat < 3 ? mat : 3) + 64 * w;
#pragma unroll
                    for (int j = 0; j < 64; j += 4) { const f32x4 g4 = *(const LAS f32x4*)(gs + j);
                        const v2f x0 = v[j] * g4.x, x1 = v[j + 1] * g4.y, x2 = v[j + 2] * g4.z, x3 = v[j + 3] * g4.w;
                        m0 = fmaxf(m0, fmaxf(fmaxf(fabsf(x0.x), fabsf(x1.x)), fmaxf(fabsf(x2.x), fabsf(x3.x))));
                        m1 = fmaxf(m1, fmaxf(fmaxf(fabsf(x0.y), fabsf(x1.y)), fmaxf(fabsf(x2.y), fabsf(x3.y))));
                        pc0[j >> 1] = pg8::cvt_pk_bf16(x0.x, x1.x); pc0[(j >> 1) + 1] = pg8::cvt_pk_bf16(x2.x, x3.x);
                        pc1[j >> 1] = pg8::cvt_pk_bf16(x0.y, x1.y); pc1[(j >> 1) + 1] = pg8::cvt_pk_bf16(x2.y, x3.y); }
                } else {
#pragma unroll
                    for (int j = 0; j < 32; ++j) { pc0[j] = 0u; pc1[j] = 0u; }
                }
                if (have) *(LAS v2f*)(pm + w * 128 + 2 * l) = (v2f){m0, m1};
                __syncthreads();
                if (have && w == 0) {
                    v2f mx = *(const LAS v2f*)(pm + 2 * l);
#pragma unroll
                    for (int q = 1; q < 8; ++q) { const v2f t = *(const LAS v2f*)(pm + q * 128 + 2 * l); mx.x = fmaxf(mx.x, t.x); mx.y = fmaxf(mx.y, t.y); }
                    (void)__hip_atomic_fetch_max(wm + n0o + 2 * l, __float_as_uint(mx.x), __ATOMIC_RELAXED, __HIP_MEMORY_SCOPE_AGENT);
                    (void)__hip_atomic_fetch_max(wm + n0o + 2 * l + 1, __float_as_uint(mx.y), __ATOMIC_RELAXED, __HIP_MEMORY_SCOPE_AGENT);
                    asm volatile("s_waitcnt vmcnt(0)" ::: "memory");
                    ++n;
                    if (l == 0) { (void)xb_add(gcnt, 1u); XB_SPIN(xb_ld(gcnt) < 8u * n, C.ctl + CW_BAR); }
                    asm volatile("" ::: "memory");
                    const unsigned u0 = xb_ld(wm + n0o + 2 * l), u1 = xb_ld(wm + n0o + 2 * l + 1);
                    *(LAS v2f*)(pm + 1024 + 2 * l) = (v2f){__uint_as_float(u0), __uint_as_float(u1)};
                }
                { const int itn = it + ngroups;
                  if (itn < NP) {
                      int rn = itn; const float* Wn; int ldn;
                      if (rn < P_UP) { Wn = C.ffn_w_up; ldn = F2; } else if ((rn -= P_UP) < P_UP) { Wn = C.ffn_w_up + (size_t)DM * F2; ldn = F2; } else if ((rn -= P_UP) < P_QKV) { Wn = C.b_w_qkv; ldn = NPROJ; }
                      else if ((rn -= P_QKV) < P_SQ) { Wn = C.a_w_out; ldn = DM; } else if ((rn -= P_SQ) < P_SQ) { Wn = C.b_w_out; ldn = DM; } else { rn -= P_SQ; Wn = C.a_w_in + 8192; ldn = ML_LD; }
                      const float* src = Wn + (size_t)(512 * member + 64 * w) * ldn + 128 * rn + 2 * l;
#pragma unroll
                      for (int j = 0; j < 64; ++j) v[j] = *(const v2f*)(src + (size_t)j * ldn);
                  } }
                __syncthreads();
                if (!have) continue;
                const v2f cc = *(const LAS v2f*)(pm + 1024 + 2 * l);
                const float c0 = cc.x, c1 = cc.y;
                const float i0 = 127.0f / fmaxf(c0, 1e-30f), i1 = 127.0f / fmaxf(c1, 1e-30f);
                signed char* dst = WT + (size_t)(n0o + 2 * l) * DM + 512 * member + 64 * w;
#pragma unroll
                for (int q = 0; q < 4; ++q) { v4u a, b;
                    a.x = pack4_i8(bflo(pc0[8 * q]) * i0, bfhi(pc0[8 * q]) * i0, bflo(pc0[8 * q + 1]) * i0, bfhi(pc0[8 * q + 1]) * i0);
                    a.y = pack4_i8(bflo(pc0[8 * q + 2]) * i0, bfhi(pc0[8 * q + 2]) * i0, bflo(pc0[8 * q + 3]) * i0, bfhi(pc0[8 * q + 3]) * i0);
                    a.z = pack4_i8(bflo(pc0[8 * q + 4]) * i0, bfhi(pc0[8 * q + 4]) * i0, bflo(pc0[8 * q + 5]) * i0, bfhi(pc0[8 * q + 5]) * i0);
                    a.w = pack4_i8(bflo(pc0[8 * q + 6]) * i0, bfhi(pc0[8 * q + 6]) * i0, bflo(pc0[8 * q + 7]) * i0, bfhi(pc0[8 * q + 7]) * i0);
                    b.x = pack4_i8(bflo(pc1[8 * q]) * i1, bfhi(pc1[8 * q]) * i1, bflo(pc1[8 * q + 1]) * i1, bfhi(pc1[8 * q + 1]) * i1);
                    b.y = pack4_i8(bflo(pc1[8 * q + 2]) * i1, bfhi(pc1[8 * q + 2]) * i1, bflo(pc1[8 * q + 3]) * i1, bfhi(pc1[8 * q + 3]) * i1);
                    b.z = pack4_i8(bflo(pc1[8 * q + 4]) * i1, bfhi(pc1[8 * q + 4]) * i1, bflo(pc1[8 * q + 5]) * i1, bfhi(pc1[8 * q + 5]) * i1);
                    b.w = pack4_i8(bflo(pc1[8 * q + 6]) * i1, bfhi(pc1[8 * q + 6]) * i1, bflo(pc1[8 * q + 7]) * i1, bfhi(pc1[8 * q + 7]) * i1);
                    *(v4u*)(dst + 16 * q) = a; *(v4u*)(dst + DM + 16 * q) = b; }
            }
        }
    }
    for (int i = C.bid * NTHR + C.tid; i < 16 * DM; i += C.G * NTHR) { const int k = i >> 4, n = i & 15; C.Wg[(size_t)n * DM + k] = (bf16)f2bf(C.a_w_in[(size_t)k * ML_LD + NPROJ + n]); }
    phase_norm_bf16(C, C.x, C.norm_mix, C.XN);
    { const int lnd = fresh_lane();
      for (int it = gw; it < 2 * I_DN; it += NGW) {
        if (it < I_DN) dn_wmax_item(C.ffn_w_down, C.ctl + CW_WMAX_DN0, it, lnd);
        else dn_wmax_item(C.ffn_w_down + (size_t)FF * DM, C.ctl + CW_WMAX_DN1, it - I_DN, lnd);
      } }
}

__device__ __forceinline__ size_t hm_off(int which, int b, int h, int t) { return ((size_t)((which * 2 + b) * 32 + h) * SEQ + t) * 128; }
__device__ __forceinline__ void scale_rows_by_rstd(f32x4 (&a)[2][2][4][2], const float* SS, int row0, int fq) {
#pragma unroll
    for (int ai = 0; ai < 2; ++ai)
#pragma unroll
        for (int m = 0; m < 4; ++m) { const f32x4* p = (const f32x4*)(SS + (size_t)(row0 + ai * 128 + m * 16) * 16 + fq * 4);
            const f32x4 s0 = p[0];
            float t = (s0.x + s0.y) + (s0.z + s0.w);
            t += __shfl_xor(t, 16); t += __shfl_xor(t, 32);
            const float rs = 1.0f / sqrtf(t * (1.0f / DM) + EPS);
#pragma unroll
            for (int bj = 0; bj < 2; ++bj)
#pragma unroll
                for (int n = 0; n < 2; ++n) a[ai][bj][m][n] = a[ai][bj][m][n] * rs; }
}
struct EpiResidBf {
    static constexpr bool PERM = true, AFTER_DRAIN = false;
    const float* base32; const bf16* base16; bf16* out; float* SS; LAS unsigned char* hl;
    __device__ __forceinline__ void operator()(const f32x4 (&acc)[2][2][4][2], const pg8::Unit& u, int wr, int wc, int fr, int fq) const {
        const int row0 = u.pm * 256 + wr * 64 + fr, col0 = u.pn * 256 + wc * 32 + 8 * fq;
        LAS float* T = (LAS float*)hl;
#pragma unroll
        for (int ai = 0; ai < 2; ++ai) {
            f32x4 b0[4][2], b1[4][2];
            if (base32) {
#pragma unroll
                for (int m = 0; m < 4; ++m)
#pragma unroll
                    for (int bj = 0; bj < 2; ++bj) { const size_t off = (size_t)(row0 + ai * 128 + m * 16) * DM + col0 + bj * 128; b0[m][bj] = *(const f32x4*)(base32 + off); b1[m][bj] = *(const f32x4*)(base32 + off + 4); }
            } else {
                v4u xb[4][2];
#pragma unroll
                for (int m = 0; m < 4; ++m)
#pragma unroll
                    for (int bj = 0; bj < 2; ++bj) xb[m][bj] = *(const v4u*)(base16 + (size_t)(row0 + ai * 128 + m * 16) * DM + col0 + bj * 128);
#pragma unroll
                for (int m = 0; m < 4; ++m)
#pragma unroll
                    for (int bj = 0; bj < 2; ++bj) { const v4u x = xb[m][bj]; b0[m][bj] = (f32x4){bflo(x.x), bfhi(x.x), bflo(x.y), bfhi(x.y)}; b1[m][bj] = (f32x4){bflo(x.z), bfhi(x.z), bflo(x.w), bfhi(x.w)}; }
            }
#pragma unroll
            for (int m = 0; m < 4; ++m) { const size_t off = (size_t)(row0 + ai * 128 + m * 16) * DM + col0; float ss = 0.f;
#pragma unroll
                for (int bj = 0; bj < 2; ++bj) {
                    const f32x4 v0 = b0[m][bj] + acc[ai][bj][m][0], v1 = b1[m][bj] + acc[ai][bj][m][1];
                    ss += ((v0[0] * v0[0] + v0[1] * v0[1]) + (v0[2] * v0[2] + v0[3] * v0[3])) + ((v1[0] * v1[0] + v1[1] * v1[1]) + (v1[2] * v1[2] + v1[3] * v1[3]));
                    v4u w; w.x = pg8::cvt_pk_bf16(v0[0], v0[1]); w.y = pg8::cvt_pk_bf16(v0[2], v0[3]); w.z = pg8::cvt_pk_bf16(v1[0], v1[1]); w.w = pg8::cvt_pk_bf16(v1[2], v1[3]);
                    *(v4u*)(out + off + bj * 128) = w; }
                ss += __shfl_xor(ss, 16); ss += __shfl_xor(ss, 32);
                if (fq == 0) T[wc * 256 + wr * 64 + fr + ai * 128 + m * 16] = ss; }
        }
        asm volatile("s_waitcnt lgkmcnt(0)" ::: "memory"); __builtin_amdgcn_s_barrier(); asm volatile("" ::: "memory");
        { const int tid = threadIdx.x; if (tid < 256) SS[(size_t)(u.pm * 256 + tid) * 16 + u.pn] = (T[tid] + T[256 + tid]) + (T[512 + tid] + T[768 + tid]); }
        asm volatile("s_waitcnt lgkmcnt(0)" ::: "memory"); __builtin_amdgcn_s_barrier(); asm volatile("" ::: "memory");
    }
};
struct EpiStoreBf16 {
    static constexpr bool PERM = true, AFTER_DRAIN = false;
    bf16* O; int ldc; const float* SS; float* KMH;
    __device__ __forceinline__ void operator()(const f32x4 (&acc)[2][2][4][2], const pg8::Unit& u, int wr, int wc, int fr, int fq) const {
        const int row0 = u.pm * 256 + wr * 64 + fr, col0 = u.pn * 256 + wc * 32 + 8 * fq;
        if (SS) scale_rows_by_rstd(const_cast<f32x4 (&)[2][2][4][2]>(acc), SS, row0, fq);
        if (KMH && u.pn >= 16 && u.pn < 32) {
#pragma unroll
            for (int bj = 0; bj < 2; ++bj)
#pragma unroll
                for (int n = 0; n < 2; ++n) { f32x4 cs = {0.f, 0.f, 0.f, 0.f};
#pragma unroll
                    for (int ai = 0; ai < 2; ++ai)
#pragma unroll
                        for (int m = 0; m < 4; ++m) cs = cs + acc[ai][bj][m][n];
#pragma unroll
                    for (int j = 0; j < 4; ++j) { float v = cs[j]; v += __shfl_xor(v, 1); v += __shfl_xor(v, 2); v += __shfl_xor(v, 4); v += __shfl_xor(v, 8); cs[j] = v; }
                    if (fr == 0) { const int c = 256 * (u.pn - 16) + 128 * bj + 32 * wc + 8 * fq + 4 * n, hh = c >> 7, d = c & 127, bb = u.pm >> 5, nb = u.pm & 31;
                        *(f32x4*)(KMH + (size_t)wr * (64 * 32 * 128) + ((size_t)((bb * 32 + hh) * 32 + nb)) * 128 + d) = cs; } }
        }
#pragma unroll
        for (int ai = 0; ai < 2; ++ai)
#pragma unroll
            for (int m = 0; m < 4; ++m) { bf16* rowp = O + (size_t)(row0 + ai * 128 + m * 16) * ldc + col0;
#pragma unroll
                for (int bj = 0; bj < 2; ++bj) { const f32x4 v0 = acc[ai][bj][m][0], v1 = acc[ai][bj][m][1];
                    v4u w; w.x = pg8::cvt_pk_bf16(v0[0], v0[1]); w.y = pg8::cvt_pk_bf16(v0[2], v0[3]); w.z = pg8::cvt_pk_bf16(v1[0], v1[1]); w.w = pg8::cvt_pk_bf16(v1[2], v1[3]);
                    *(v4u*)(rowp + bj * 128) = w; } }
    }
};
struct EpiResid {
    static constexpr bool PERM = false, AFTER_DRAIN = false;
    const float* base; float* out; int ldc;
    __device__ __forceinline__ void operator()(const f32x4 (&acc)[2][2][4][2], const pg8::Unit& u, int wr, int wc, int fr, int fq) const {
        const int row0 = u.pm * 256 + wr * 64 + fr, col0 = u.pn * 256 + wc * 32 + 4 * fq;
#pragma unroll
        for (int ai = 0; ai < 2; ++ai)
#pragma unroll
            for (int m = 0; m < 4; ++m) { const size_t off = (size_t)(row0 + ai * 128 + m * 16) * ldc + col0;
#pragma unroll
                for (int bj = 0; bj < 2; ++bj)
#pragma unroll
                    for (int n = 0; n < 2; ++n) { const f32x4 bs = *(const f32x4*)(base + off + bj * 128 + n * 16); *(f32x4*)(out + off + bj * 128 + n * 16) = bs + acc[ai][bj][m][n]; } }
    }
};
template <int CTRL> __device__ __forceinline__ float dppf_old(float old, float v) { return __builtin_bit_cast(float, __builtin_amdgcn_update_dpp(__builtin_bit_cast(int, old), __builtin_bit_cast(int, v), CTRL, 0xF, 0xF, false)); }
__device__ __forceinline__ float silu_mul(float g, float u) { return g * __builtin_amdgcn_rcpf(1.0f + __builtin_amdgcn_exp2f(-1.4426950408889634f * g)) * u; }
typedef int i32x4 __attribute__((ext_vector_type(4)));
struct ConvActArgs { bf16* ACT; const float* cw; const float* cb; float* HALO; float* HEAD; LAS unsigned char* hl; };
__device__ __forceinline__ void conv_taps_dma(const ConvActArgs& P, const pg8::Unit& u, int wr, int wc, int fr, int fq) {
    const float* cw = P.cw; const float* cb = P.cb; LAS unsigned char* hl = P.hl;
    { const int wid = wr * 4 + wc, arr = wid >> 1, half = wid & 1, lane = fq * 16 + fr;
      const float* src = (arr < 3 ? cw + (size_t)arr * F2 : cb) + half * FF + 128 * u.pn;
      LAS unsigned* dst = (LAS unsigned*)(hl + 8192 + wid * 512);
      __builtin_amdgcn_global_load_lds((const unsigned*)(src + lane), dst, 4, 0, 0);
      __builtin_amdgcn_global_load_lds((const unsigned*)(src + 64 + lane), dst + 64, 4, 0, 0); }
}
struct AccViewF { const f32x4 (&a)[2][2][4][2]; __device__ __forceinline__ f32x4 operator()(int ai, int bj, int m, int n) const { return a[ai][bj][m][n]; } };
struct AccViewI { const i32x4 (&a)[2][2][4][2]; __device__ __forceinline__ f32x4 operator()(int ai, int bj, int m, int n) const { return __builtin_bit_cast(f32x4, a[ai][bj][m][n]); } };
template <class View>
__device__ __forceinline__ void conv_act_body(const View& A, const ConvActArgs& P, const pg8::Unit& u, int wr, int wc, int fr, int fq) {
    bf16* ACT = P.ACT; float* HALO = P.HALO; float* HEAD = P.HEAD; LAS unsigned char* hl = P.hl;
    {
        const int cbase = wc * 32 + 8 * fq;
#pragma unroll
        for (int ai = 0; ai < 2; ++ai)
#pragma unroll
            for (int bj = 0; bj < 2; ++bj)
#pragma unroll
                for (int n = 0; n < 2; ++n) if (fr >= 14) *(LAS f32x4*)(hl + ((((ai * 2 + wr) * 2 + (fr - 14)) * 256 + 128 * bj + cbase + 4 * n) * 4)) = A(ai, bj, 3, n);
        if (wr == 1 && fr >= 14) {
#pragma unroll
            for (int bj = 0; bj < 2; ++bj)
#pragma unroll
                for (int n = 0; n < 2; ++n) *(f32x4*)(HALO + (size_t)(u.pm * 2 + fr - 14) * F2 + 256 * u.pn + 128 * bj + cbase + 4 * n) = A(1, bj, 3, n);
        }
        if (wr == 0 && fr < 2) {
#pragma unroll
            for (int bj = 0; bj < 2; ++bj)
#pragma unroll
                for (int n = 0; n < 2; ++n) *(f32x4*)(HEAD + (size_t)(u.pm * 2 + fr) * F2 + 256 * u.pn + 128 * bj + cbase + 4 * n) = A(0, bj, 0, n);
        }
        asm volatile("s_waitcnt vmcnt(4) lgkmcnt(0)" ::: "memory"); __builtin_amdgcn_s_barrier(); asm volatile("" ::: "memory");
        const int row0 = u.pm * 256 + wr * 64 + fr;
#pragma unroll
        for (int n = 0; n < 2; ++n) {
            const LAS unsigned char* wl = hl + 8192 + (cbase + 4 * n) * 4;
#pragma unroll
            for (int ai = 0; ai < 2; ++ai)
#pragma unroll
                for (int m = 0; m < 4; ++m) {
                    const f32x4 cg = A(ai, 0, m, n), cu = A(ai, 1, m, n);
                    f32x4 pg1, pg2, pu1, pu2;
                    if (m == 0) {
                        f32x4 g14 = {0.f, 0.f, 0.f, 0.f}, g15 = g14, u14 = g14, u15 = g14;
                        if (wr == 1 || ai == 1) { const int grp = (wr == 1) ? ai * 2 : 1; const LAS unsigned char* hb = hl + ((grp * 2) * 256 + cbase + 4 * n) * 4;
                            g14 = *(const LAS f32x4*)hb; g15 = *(const LAS f32x4*)(hb + 1024); u14 = *(const LAS f32x4*)(hb + 512); u15 = *(const LAS f32x4*)(hb + 1536); }
#pragma unroll
                        for (int j = 0; j < 4; ++j) {
                            pg1[j] = dppf_old<0x111>(g15[j], cg[j]); pg2[j] = dppf_old<0x112>(fr == 0 ? g14[j] : g15[j], cg[j]);
                            pu1[j] = dppf_old<0x111>(u15[j], cu[j]); pu2[j] = dppf_old<0x112>(fr == 0 ? u14[j] : u15[j], cu[j]); }
                    } else {
                        const f32x4 qg = A(ai, 0, m > 0 ? m - 1 : 0, n), qu = A(ai, 1, m > 0 ? m - 1 : 0, n);
#pragma unroll
                        for (int j = 0; j < 4; ++j) {
                            pg1[j] = dppf_old<0x111>(dppf<0x121>(qg[j]), cg[j]); pg2[j] = dppf_old<0x112>(dppf<0x122>(qg[j]), cg[j]);
                            pu1[j] = dppf_old<0x111>(dppf<0x121>(qu[j]), cu[j]); pu2[j] = dppf_old<0x112>(dppf<0x122>(qu[j]), cu[j]); }
                    }
                    const f32x4 wg0 = *(const LAS f32x4*)(wl), wg1 = *(const LAS f32x4*)(wl + 1024), wg2 = *(const LAS f32x4*)(wl + 2048), bg = *(const LAS f32x4*)(wl + 3072);
                    const f32x4 gv = bg + wg0 * pg2 + wg1 * pg1 + wg2 * cg;
                    const f32x4 wu0 = *(const LAS f32x4*)(wl + 512), wu1 = *(const LAS f32x4*)(wl + 1536), wu2 = *(const LAS f32x4*)(wl + 2560), bu = *(const LAS f32x4*)(wl + 3584);
                    const f32x4 uv = bu + wu0 * pu2 + wu1 * pu1 + wu2 * cu;
                    v2u pk; pk.x = pg8::cvt_pk_bf16(silu_mul(gv[0], uv[0]), silu_mul(gv[1], uv[1])); pk.y = pg8::cvt_pk_bf16(silu_mul(gv[2], uv[2]), silu_mul(gv[3], uv[3]));
                    *(v2u*)(ACT + (size_t)(row0 + ai * 128 + m * 16) * FF + 128 * u.pn + cbase + 4 * n) = pk;
                }
        }
    }
}
struct EpiConvAct {
    static constexpr bool PERM = true, AFTER_DRAIN = false;
    ConvActArgs P; const float* SS;
    __device__ __forceinline__ void operator()(const f32x4 (&acc)[2][2][4][2], const pg8::Unit& u, int wr, int wc, int fr, int fq) const {
        conv_taps_dma(P, u, wr, wc, fr, fq);
        scale_rows_by_rstd(const_cast<f32x4 (&)[2][2][4][2]>(acc), SS, u.pm * 256 + wr * 64 + fr, fq);
        conv_act_body(AccViewF{acc}, P, u, wr, wc, fr, fq);
    }
};
__device__ __forceinline__ void phase_conv_fixup(const Ctx& C0, int layer) {
    Ctx C = C0; C.lane = fresh_lane(); C.tid = C.wave * 64 + C.lane;
    const float* cw = C.ffn_conv_w + (size_t)layer * 3 * F2; const float* cb = C.ffn_conv_b + (size_t)layer * F2;
    constexpr int NQ = FF / 4;
    for (int idx = C.bid * NTHR + C.tid; idx < 64 * NQ; idx += C.G * NTHR) {
        const int pm = idx / NQ, c = (idx % NQ) * 4;
        if ((pm & 31) == 0) continue;
        const int pc = (c >> 7) * 256 + (c & 127);
        const f32x4 wg0 = *(const f32x4*)(cw + c), wg1 = *(const f32x4*)(cw + F2 + c), wg2 = *(const f32x4*)(cw + 2 * F2 + c), bg = *(const f32x4*)(cb + c);
        const f32x4 wu0 = *(const f32x4*)(cw + FF + c), wu1 = *(const f32x4*)(cw + F2 + FF + c), wu2 = *(const f32x4*)(cw + 2 * F2 + FF + c), bu = *(const f32x4*)(cb + FF + c);
        const f32x4 gm2 = *(const f32x4*)(C.HALO + (size_t)((pm - 1) * 2) * F2 + pc), gm1 = *(const f32x4*)(C.HALO + (size_t)((pm - 1) * 2 + 1) * F2 + pc);
        const f32x4 g0 = *(const f32x4*)(C.HEAD + (size_t)(pm * 2) * F2 + pc), g1 = *(const f32x4*)(C.HEAD + (size_t)(pm * 2 + 1) * F2 + pc);
        const f32x4 um2 = *(const f32x4*)(C.HALO + (size_t)((pm - 1) * 2) * F2 + pc + 128), um1 = *(const f32x4*)(C.HALO + (size_t)((pm - 1) * 2 + 1) * F2 + pc + 128);
        const f32x4 u0 = *(const f32x4*)(C.HEAD + (size_t)(pm * 2) * F2 + pc + 128), u1 = *(const f32x4*)(C.HEAD + (size_t)(pm * 2 + 1) * F2 + pc + 128);
        const f32x4 ga = bg + wg0 * gm2 + wg1 * gm1 + wg2 * g0, ua = bu + wu0 * um2 + wu1 * um1 + wu2 * u0;
        const f32x4 gb = bg + wg0 * gm1 + wg1 * g0 + wg2 * g1, ub = bu + wu0 * um1 + wu1 * u0 + wu2 * u1;
        v2u a, b2;
        a.x = pg8::cvt_pk_bf16(silu_mul(ga[0], ua[0]), silu_mul(ga[1], ua[1])); a.y = pg8::cvt_pk_bf16(silu_mul(ga[2], ua[2]), silu_mul(ga[3], ua[3]));
        b2.x = pg8::cvt_pk_bf16(silu_mul(gb[0], ub[0]), silu_mul(gb[1], ub[1])); b2.y = pg8::cvt_pk_bf16(silu_mul(gb[2], ub[2]), silu_mul(gb[3], ub[3]));
        *(v2u*)(C.ACT + (size_t)(pm * 256) * FF + c) = a; *(v2u*)(C.ACT + (size_t)(pm * 256 + 1) * FF + c) = b2;
    }
}
__device__ __forceinline__ f32x4 cvt_i32x4(i32x4 v) { return (f32x4){(float)v[0], (float)v[1], (float)v[2], (float)v[3]}; }
struct EpiResidBfI8 {
    static constexpr bool PERM = true, AFTER_DRAIN = false;
    const float* base32; const bf16* base16; bf16* out; float* SS; LAS unsigned char* hl; const float* SA; const unsigned* wmax;
    __device__ __forceinline__ void operator()(const i32x4 (&acc)[2][2][4][2], const pg8::Unit& u, int wr, int wc, int fr, int fq) const {
        const int row0 = u.pm * 256 + wr * 64 + fr, col0 = u.pn * 256 + wc * 32 + 8 * fq;
        v4u wraw[2][2]; float sa[2][4];
#pragma unroll
        for (int bj = 0; bj < 2; ++bj)
#pragma unroll
            for (int n = 0; n < 2; ++n) wraw[bj][n] = *(const v4u*)(wmax + col0 + bj * 128 + 4 * n);
#pragma unroll
        for (int ai = 0; ai < 2; ++ai)
#pragma unroll
            for (int m = 0; m < 4; ++m) sa[ai][m] = SA[row0 + ai * 128 + m * 16];
        v4u rb[4][2][2][2];
        auto LQ = [&](const int q) { const int ai = q >> 1, mh = q & 1;
#pragma unroll
            for (int mm = 0; mm < 2; ++mm)
#pragma unroll
                for (int bj = 0; bj < 2; ++bj) { const size_t off = (size_t)(row0 + ai * 128 + (2 * mh + mm) * 16) * DM + col0 + bj * 128;
                    if (base32) { rb[q][mm][bj][0] = *(const v4u*)(base32 + off); rb[q][mm][bj][1] = *(const v4u*)(base32 + off + 4); }
                    else rb[q][mm][bj][0] = *(const v4u*)(base16 + off); } };
        f32x4 sb[2][2];
        auto CQ = [&](const int q) { const int ai = q >> 1, mh = q & 1;
#pragma unroll
            for (int mm = 0; mm < 2; ++mm) { const int m = 2 * mh + mm; const size_t off = (size_t)(row0 + ai * 128 + m * 16) * DM + col0;
#pragma unroll
                for (int bj = 0; bj < 2; ++bj) { f32x4 b0, b1;
                    if (base32) { b0 = __builtin_bit_cast(f32x4, rb[q][mm][bj][0]); b1 = __builtin_bit_cast(f32x4, rb[q][mm][bj][1]); }
                    else { const v4u x = rb[q][mm][bj][0]; b0 = (f32x4){bflo(x.x), bfhi(x.x), bflo(x.y), bfhi(x.y)}; b1 = (f32x4){bflo(x.z), bfhi(x.z), bflo(x.w), bfhi(x.w)}; }
                    const f32x4 v0 = b0 + cvt_i32x4(acc[ai][bj][m][0]) * (sb[bj][0] * sa[ai][m]), v1 = b1 + cvt_i32x4(acc[ai][bj][m][1]) * (sb[bj][1] * sa[ai][m]);
                    v4u w; w.x = pg8::cvt_pk_bf16(v0[0], v0[1]); w.y = pg8::cvt_pk_bf16(v0[2], v0[3]); w.z = pg8::cvt_pk_bf16(v1[0], v1[1]); w.w = pg8::cvt_pk_bf16(v1[2], v1[3]);
                    *(v4u*)(out + off + bj * 128) = w; } } };
        LQ(0);
#pragma unroll
        for (int bj = 0; bj < 2; ++bj)
#pragma unroll
            for (int n = 0; n < 2; ++n) { const v4u w = wraw[bj][n]; sb[bj][n] = (f32x4){__uint_as_float(w.x), __uint_as_float(w.y), __uint_as_float(w.z), __uint_as_float(w.w)} * (1.0f / 127.0f); }
        if (base32) { CQ(0); LQ(1); CQ(1); LQ(2); CQ(2); LQ(3); CQ(3); }
        else { LQ(1); CQ(0); LQ(2); CQ(1); LQ(3); CQ(2); CQ(3); }
    }
};
struct EpiStoreBf16I8 {
    static constexpr bool PERM = true, AFTER_DRAIN = false;
    bf16* O; int ldc; const float* SS; float* KMH; const float* SA; const unsigned* wmax; bool HM;
    __device__ __forceinline__ void operator()(const i32x4 (&acc)[2][2][4][2], const pg8::Unit& u, int wr, int wc, int fr, int fq) const {
        const int row0 = u.pm * 256 + wr * 64 + fr, col0 = u.pn * 256 + wc * 32 + 8 * fq;
        float rsc[2][4];
        { f32x4 s0[2][4];
#pragma unroll
          for (int ai = 0; ai < 2; ++ai)
#pragma unroll
              for (int m = 0; m < 4; ++m) { const int row = row0 + ai * 128 + m * 16; rsc[ai][m] = SA[row]; s0[ai][m] = SS ? *(const f32x4*)(SS + (size_t)row * 16 + fq * 4) : (f32x4){0.f, 0.f, 0.f, 0.f}; }
          if (SS) {
#pragma unroll
              for (int ai = 0; ai < 2; ++ai)
#pragma unroll
                  for (int m = 0; m < 4; ++m) { float t = (s0[ai][m].x + s0[ai][m].y) + (s0[ai][m].z + s0[ai][m].w); t += __shfl_xor(t, 16); t += __shfl_xor(t, 32);
                      rsc[ai][m] = rsc[ai][m] / sqrtf(t * (1.0f / DM) + EPS); } } }
        f32x4 sb[2][2];
#pragma unroll
        for (int bj = 0; bj < 2; ++bj)
#pragma unroll
            for (int n = 0; n < 2; ++n) { const v4u w = *(const v4u*)(wmax + col0 + bj * 128 + 4 * n); sb[bj][n] = (f32x4){__uint_as_float(w.x), __uint_as_float(w.y), __uint_as_float(w.z), __uint_as_float(w.w)} * (1.0f / 127.0f); }
        if (KMH && u.pn >= 16 && u.pn < 32) {
#pragma unroll
            for (int bj = 0; bj < 2; ++bj)
#pragma unroll
                for (int n = 0; n < 2; ++n) { f32x4 cs = {0.f, 0.f, 0.f, 0.f};
#pragma unroll
                    for (int ai = 0; ai < 2; ++ai)
#pragma unroll
                        for (int m = 0; m < 4; ++m) cs = cs + cvt_i32x4(acc[ai][bj][m][n]) * rsc[ai][m];
                    cs = cs * sb[bj][n];
#pragma unroll
                    for (int j = 0; j < 4; ++j) { float v = cs[j]; v += __shfl_xor(v, 1); v += __shfl_xor(v, 2); v += __shfl_xor(v, 4); v += __shfl_xor(v, 8); cs[j] = v; }
                    if (fr == 0) { const int c = 256 * (u.pn - 16) + 128 * bj + 32 * wc + 8 * fq + 4 * n, hh = c >> 7, d = c & 127, bb = u.pm >> 5, nb = u.pm & 31;
                        *(f32x4*)(KMH + (size_t)wr * (64 * 32 * 128) + ((size_t)((bb * 32 + hh) * 32 + nb)) * 128 + d) = cs; } }
        }
#pragma unroll
        for (int ai = 0; ai < 2; ++ai)
#pragma unroll
            for (int m = 0; m < 4; ++m) { const int tok = row0 + ai * 128 + m * 16; bf16* rowp = O + (size_t)tok * ldc + col0;
#pragma unroll
                for (int bj = 0; bj < 2; ++bj) { const f32x4 v0 = cvt_i32x4(acc[ai][bj][m][0]) * (sb[bj][0] * rsc[ai][m]), v1 = cvt_i32x4(acc[ai][bj][m][1]) * (sb[bj][1] * rsc[ai][m]);
                    v4u w; w.x = pg8::cvt_pk_bf16(v0[0], v0[1]); w.y = pg8::cvt_pk_bf16(v0[2], v0[3]); w.z = pg8::cvt_pk_bf16(v1[0], v1[1]); w.w = pg8::cvt_pk_bf16(v1[2], v1[3]);
                    bf16* dst = HM ? O + hm_off(u.pn >> 4, tok >> 13, (u.pn & 15) * 2 + bj, tok & (SEQ - 1)) + wc * 32 + 8 * fq : rowp + bj * 128;
                    *(v4u*)dst = w; } }
    }
};
struct EpiConvActI8 {
    static constexpr bool PERM = true, AFTER_DRAIN = false;
    ConvActArgs P; const float* SS; const float* SA; const unsigned* wmax;
    __device__ __forceinline__ void operator()(const i32x4 (&acc)[2][2][4][2], const pg8::Unit& u, int wr, int wc, int fr, int fq) const {
        conv_taps_dma(P, u, wr, wc, fr, fq);
        __builtin_amdgcn_sched_barrier(0);
        const int row0 = u.pm * 256 + wr * 64 + fr, col0 = u.pn * 256 + wc * 32 + 8 * fq;
        float rsc[2][4];
#pragma unroll
        for (int ai = 0; ai < 2; ++ai)
#pragma unroll
            for (int m = 0; m < 4; ++m) rsc[ai][m] = SA[row0 + ai * 128 + m * 16];
        i32x4 (&ia)[2][2][4][2] = const_cast<i32x4 (&)[2][2][4][2]>(acc);
        v4u wraw[2][2];
#pragma unroll
        for (int bj = 0; bj < 2; ++bj)
#pragma unroll
            for (int n = 0; n < 2; ++n) wraw[bj][n] = *(const v4u*)(wmax + col0 + bj * 128 + 4 * n);
        __builtin_amdgcn_sched_barrier(0);
#pragma unroll
        for (int bj = 0; bj < 2; ++bj)
#pragma unroll
            for (int n = 0; n < 2; ++n) { const v4u w = wraw[bj][n];
                const f32x4 sb = (f32x4){__uint_as_float(w.x), __uint_as_float(w.y), __uint_as_float(w.z), __uint_as_float(w.w)} * (1.0f / 127.0f);
#pragma unroll
                for (int ai = 0; ai < 2; ++ai)
#pragma unroll
                    for (int m = 0; m < 4; ++m) ia[ai][bj][m][n] = __builtin_bit_cast(i32x4, cvt_i32x4(ia[ai][bj][m][n]) * (sb * rsc[ai][m])); }
        conv_act_body(AccViewI{acc}, P, u, wr, wc, fr, fq);
    }
};
template <class Epi>
__device__ __forceinline__ void run_gemm_i8(const Ctx& C, const signed char* A8, const signed char* B8, int N, int K, const Epi& E) {
    pg8::Gemm g{(const bf16*)A8, (const bf16*)B8, MTOK, N, K / 2}; pg8::StaticOrder S; S.init(MTOK, N, C.G, C.bid);
    pg8::gemm_phase_i8<Epi, pg8::StaticOrder, true, true>(C.lds, g, S, E);
}
template <class Epi>
__device__ __forceinline__ void run_gemm(const Ctx& C, const bf16* A, const bf16* Bt, int N, int K, const Epi& E) {
    pg8::Gemm g{A, Bt, MTOK, N, K}; pg8::StaticOrder S; S.init(MTOK, N, C.G, C.bid);
    pg8::gemm_phase<Epi, pg8::StaticOrder, true, true>(C.lds, g, S, E);
}

__device__ __forceinline__ void phase_gates(const Ctx& C0) {
    Ctx C = C0; C.lane = fresh_lane(); C.tid = C.wave * 64 + C.lane;
    const int gw = C.bid * NWAVES + C.wave, NGW = C.G * NWAVES, l = C.lane, g = l >> 4;
    for (int task = gw; task < (MTOK / 16) * 4; task += NGW) {
        const int tile = task >> 2, kp = task & 3;
        const bf16* ar = C.XN + (size_t)(tile * 16 + (l & 15)) * DM + kp * 1024 + g * 8;
        const bf16* br = C.Wg + (size_t)(l & 15) * DM + kp * 1024 + g * 8;
        f32x4 acc = {0.f, 0.f, 0.f, 0.f};
#pragma unroll 16
        for (int s = 0; s < 32; ++s) acc = mfma16(*(const bf16x8*)(ar + 32 * s), *(const bf16x8*)(br + 32 * s), acc);
#pragma unroll
        for (int r = 0; r < 4; ++r) C.GATES[((size_t)kp * MTOK + tile * 16 + 4 * g + r) * 16 + (l & 15)] = acc[r];
    }
}
__device__ __forceinline__ float softcap15(float v) { return 15.0f * tanhf(v * (1.0f / 15.0f)); }
__device__ __forceinline__ float logsig(float v) { return fminf(v, 0.f) - log1pf(expf(-fabsf(v))); }
__device__ __forceinline__ void phase_gate_scan(const Ctx& C0) {
    Ctx C = C0; C.lane = fresh_lane(); C.tid = C.wave * 64 + C.lane;
    if (C.bid >= 16) return;
    const int bh = C.bid, b = bh >> 3, h = bh & 7, tid = C.tid, lane = C.lane, wave = C.wave;
    LAS float* red = (LAS float*)C.lds;
    const float bi = C.a_gate_bias[h], bf_ = C.a_gate_bias[8 + h];
    float a[16], lf[16];
    float c = 0.f;
#pragma unroll
    for (int q = 0; q < 16; ++q) { a[q] = bi; lf[q] = bf_; }
#pragma unroll
    for (int kp = 0; kp < 4; ++kp)
#pragma unroll
        for (int q = 0; q < 16; ++q) { const size_t row = (size_t)b * SEQ + tid * 16 + q; a[q] += C.GATES[((size_t)kp * MTOK + row) * 16 + h]; lf[q] += C.GATES[((size_t)kp * MTOK + row) * 16 + 8 + h]; }
#pragma unroll
    for (int q = 0; q < 16; ++q) { a[q] = softcap15(a[q]); c += logsig(softcap15(lf[q])); lf[q] = c; }
    float inc = c;
#pragma unroll
    for (int o = 1; o < 64; o <<= 1) { const float t = __shfl_up(inc, o); if (lane >= o) inc += t; }
    if (lane == 63) red[wave] = inc;
    __syncthreads();
    float base = 0.f;
    for (int w = 0; w < wave; ++w) base += red[w];
    const float ex = base + inc - c;
    float mloc = -INFINITY;
#pragma unroll
    for (int q = 0; q < 16; ++q) { const float F = ex + lf[q]; const size_t o = (size_t)bh * SEQ + tid * 16 + q; C.FFv[o] = F; a[q] = a[q] - F; C.FA[o] = a[q]; mloc = fmaxf(mloc, a[q]); lf[q] = mloc; }
    float minc = mloc;
#pragma unroll
    for (int o = 1; o < 64; o <<= 1) { const float t = __shfl_up(minc, o); if (lane >= o) minc = fmaxf(minc, t); }
    __syncthreads();
    if (lane == 63) red[16 + wave] = minc;
    __syncthreads();
    float pm = 0.f;
    for (int w = 0; w < wave; ++w) pm = fmaxf(pm, red[16 + w]);
    { const float t = __shfl_up(minc, 1); if (lane >= 1) pm = fmaxf(pm, t); }
#pragma unroll
    for (int q = 0; q < 16; ++q) C.FG[(size_t)bh * SEQ + tid * 16 + q] = fmaxf(pm, lf[q]);
}
__device__ __forceinline__ void phase_mlstm_u(const Ctx& C0) {
    Ctx C = C0; C.lane = fresh_lane(); C.tid = C.wave * 64 + C.lane;
    LAS bf16* KT = (LAS bf16*)C.lds;
    LAS bf16* VT = (LAS bf16*)(C.lds + 69632);
    const int tid = C.tid, l = C.lane, g = l >> 4, w = C.wave;
    for (int u = C.bid; u < 1024; u += C.G) {
        const int bh = u >> 6, c = u & 63, b = bh >> 3, h = bh & 7, tokbase = b * SEQ + c * 128;
        const float Rc = C.FG[(size_t)bh * SEQ + c * 128 + 127];
        __syncthreads();
        const int i = tid & 127, cg = tid >> 7;
        const float wi = expf(C.FA[(size_t)bh * SEQ + c * 128 + i] - Rc) * 0.0625f;
        const bf16* krow = C.PROJ + (size_t)(tokbase + i) * NPROJ + 2048 + h * 256;
        { v4u kx[8];
#pragma unroll
          for (int k = 0; k < 8; ++k) kx[k] = *(const v4u*)(krow + (cg + 4 * k) * 8);
#pragma unroll
          for (int k = 0; k < 8; ++k) { const v4u x = kx[k]; LAS bf16* dst = KT + ((cg + 4 * k) * 8) * 136 + i;
            const unsigned p0 = pg8::cvt_pk_bf16(bflo(x.x) * wi, bfhi(x.x) * wi), p1 = pg8::cvt_pk_bf16(bflo(x.y) * wi, bfhi(x.y) * wi), p2 = pg8::cvt_pk_bf16(bflo(x.z) * wi, bfhi(x.z) * wi), p3 = pg8::cvt_pk_bf16(bflo(x.w) * wi, bfhi(x.w) * wi);
            dst[0 * 136] = (bf16)(p0 & 0xffffu); dst[1 * 136] = (bf16)(p0 >> 16); dst[2 * 136] = (bf16)(p1 & 0xffffu); dst[3 * 136] = (bf16)(p1 >> 16);
            dst[4 * 136] = (bf16)(p2 & 0xffffu); dst[5 * 136] = (bf16)(p2 >> 16); dst[6 * 136] = (bf16)(p3 & 0xffffu); dst[7 * 136] = (bf16)(p3 >> 16); } }
        bf16x8 af[2][4];
#pragma unroll 1
        for (int ec = 0; ec < 3; ++ec) {
            if (ec > 0) __syncthreads();
            const bf16* vrow = C.PROJ + (size_t)(tokbase + i) * NPROJ + 4096 + h * 512 + ec * 176;
            v4u vxx[6];
#pragma unroll
            for (int k = 0; k < 6; ++k) { const int ch = cg + 4 * k; vxx[k] = (ch < 22 && ec * 176 + ch * 8 < 512) ? *(const v4u*)(vrow + ch * 8) : (v4u){0u, 0u, 0u, 0u}; }
#pragma unroll
            for (int k = 0; k < 6; ++k) { const int ch = cg + 4 * k; if (ch >= 22) continue; const int e0 = ec * 176 + ch * 8; LAS bf16* dst = VT + (ch * 8) * 136 + i;
                if (e0 < 512) { const v4u x = vxx[k];
                    dst[0 * 136] = (bf16)(x.x & 0xffffu); dst[1 * 136] = (bf16)(x.x >> 16); dst[2 * 136] = (bf16)(x.y & 0xffffu); dst[3 * 136] = (bf16)(x.y >> 16);
                    dst[4 * 136] = (bf16)(x.z & 0xffffu); dst[5 * 136] = (bf16)(x.z >> 16); dst[6 * 136] = (bf16)(x.w & 0xffffu); dst[7 * 136] = (bf16)(x.w >> 16);
                } else {
#pragma unroll
                    for (int jj = 0; jj < 8; ++jj) dst[jj * 136] = (bf16)((e0 + jj == 512) ? 0x3F80u : 0u); } }
            __syncthreads();
            if (ec == 0) {
#pragma unroll
                for (int mt = 0; mt < 2; ++mt)
#pragma unroll
                    for (int s = 0; s < 4; ++s) af[mt][s] = *(const LAS bf16x8*)(KT + (16 * (2 * w + mt) + (l & 15)) * 136 + s * 32 + g * 8);
            }
#pragma unroll 1
            for (int et = 0; et < 11; ++et) {
                bf16x8 bfr[4];
#pragma unroll
                for (int s = 0; s < 4; ++s) bfr[s] = *(const LAS bf16x8*)(VT + (16 * et + (l & 15)) * 136 + s * 32 + g * 8);
                const int e = ec * 176 + 16 * et + (l & 15);
#pragma unroll
                for (int mt = 0; mt < 2; ++mt) { f32x4 acc = {0.f, 0.f, 0.f, 0.f};
#pragma unroll
                    for (int s = 0; s < 4; ++s) acc = mfma16(af[mt][s], bfr[s], acc);
                    v2u o; o.x = pk2(acc[0], acc[1]); o.y = pk2(acc[2], acc[3]);
                    *(v2u*)(C.UT + ((size_t)u * 528 + e) * 256 + 16 * (2 * w + mt) + 4 * g) = o; }
            }
        }
    }
}
__device__ __forceinline__ void phase_mlstm_scan(const Ctx& C0) {
    Ctx C = C0; C.lane = fresh_lane(); C.tid = C.wave * 64 + C.lane;
    constexpr int GRP = 528 * 256 / 8;
    for (int gi = C.bid * NTHR + C.tid; gi < 16 * GRP; gi += C.G * NTHR) {
        const int bh = gi / GRP; const size_t off = (size_t)(gi % GRP) * 8;
        float s[8];
#pragma unroll
        for (int j = 0; j < 8; ++j) s[j] = 0.f;
        float Rprev = 0.f;
#pragma unroll 1
        for (int c0 = 0; c0 < 63; c0 += 8) {
            v4u ux[8]; float rc[8];
#pragma unroll
            for (int k = 0; k < 8; ++k) { const int c = (c0 + k < 63) ? c0 + k : 62; ux[k] = *(const v4u*)(C.UT + (size_t)(bh * 64 + c) * (528 * 256) + off); rc[k] = C.FG[(size_t)bh * SEQ + c * 128 + 127]; }
#pragma unroll
            for (int k = 0; k < 8; ++k) {
                if (c0 + k < 63) {
                    const v4u x = ux[k]; const float a = __builtin_amdgcn_exp2f((Rprev - rc[k]) * 1.4426950408889634f); Rprev = rc[k];
                    s[0] = a * s[0] + bflo(x.x); s[1] = a * s[1] + bfhi(x.x); s[2] = a * s[2] + bflo(x.y); s[3] = a * s[3] + bfhi(x.y);
                    s[4] = a * s[4] + bflo(x.z); s[5] = a * s[5] + bfhi(x.z); s[6] = a * s[6] + bflo(x.w); s[7] = a * s[7] + bfhi(x.w);
                    v4u o; o.x = pg8::cvt_pk_bf16(s[0], s[1]); o.y = pg8::cvt_pk_bf16(s[2], s[3]); o.z = pg8::cvt_pk_bf16(s[4], s[5]); o.w = pg8::cvt_pk_bf16(s[6], s[7]);
                    *(v4u*)(C.ST + (size_t)(bh * 64 + c0 + k + 1) * (528 * 256) + off) = o;
                }
            }
        }
    }
}
__device__ __forceinline__ void phase_mlstm_out(const Ctx& C0) {
    Ctx C = C0; C.lane = fresh_lane(); C.tid = C.wave * 64 + C.lane;
    LAS unsigned char* X = C.lds;
    LAS unsigned char* Y = C.lds + 110592;
    const int tid = C.tid, l = C.lane, g = l >> 4, w = C.wave;
    LAS bf16* Pw = (LAS bf16*)(C.lds + 75776 + w * 4352);
    LAS float* fa = (LAS float*)(C.lds + 145408); LAS float* fg = fa + 128; LAS float* ff = fa + 256; LAS float* fa_rs = fa + 384;
    for (int u = C.bid; u < 1024; u += C.G) {
        const int bh = u >> 6, c = u & 63, b = bh >> 3, h = bh & 7, tokbase = b * SEQ + c * 128;
        const float Rprev = (c == 0) ? 0.f : C.FG[(size_t)bh * SEQ + c * 128 - 1];
        __syncthreads();
        { v4u kt8[8];
#pragma unroll
          for (int it = 0; it < 8; ++it) { const int q = tid + 512 * it, key = q >> 5, ch = q & 31; kt8[it] = *(const v4u*)(C.PROJ + (size_t)(tokbase + key) * NPROJ + 2048 + h * 256 + ch * 8); }
#pragma unroll
          for (int it = 0; it < 8; ++it) { const int q = tid + 512 * it, key = q >> 5, ch = q & 31; *(LAS v4u*)(X + key * 528 + ch * 16) = kt8[it]; } }
        if (tid < 128) { const size_t o = (size_t)bh * SEQ + c * 128 + tid; fa[tid] = C.FA[o]; fg[tid] = C.FG[o]; ff[tid] = C.FFv[o]; }
        bf16x8 qf[8];
        { const bf16* qrow = C.PROJ + (size_t)(tokbase + 16 * w + (l & 15)) * NPROJ + h * 256 + g * 8;
#pragma unroll
          for (int s = 0; s < 8; ++s) qf[s] = *(const bf16x8*)(qrow + 32 * s); }
        __syncthreads();
#pragma unroll
        for (int kt = 0; kt < 8; ++kt) {
            f32x4 sa = {0.f, 0.f, 0.f, 0.f};
#pragma unroll
            for (int s = 0; s < 8; ++s) sa = mfma16(qf[s], *(const LAS bf16x8*)(X + (16 * kt + (l & 15)) * 528 + s * 64 + g * 16), sa);
            const int ikey = 16 * kt + (l & 15);
#pragma unroll
            for (int r = 0; r < 4; ++r) { const int jrow = 16 * w + 4 * g + r;
                const float val = (ikey <= jrow) ? sa[r] * __builtin_amdgcn_exp2f(fminf(fa[ikey] - fg[jrow], 0.f) * 1.4426950408889634f) * 0.0625f : 0.f;
                Pw[(4 * g + r) * 136 + ikey] = (bf16)(pg8::cvt_pk_bf16(val, val) & 0xffffu); }
            __builtin_amdgcn_sched_barrier(0);
        }
        LDS_WAIT();
        bf16x8 pf[4];
#pragma unroll
        for (int ks = 0; ks < 4; ++ks) pf[ks] = *(const LAS bf16x8*)(Pw + (l & 15) * 136 + ks * 32 + g * 8);
        float sc[4], inv[4], ss[4] = {0.f, 0.f, 0.f, 0.f};
#pragma unroll
        for (int r = 0; r < 4; ++r) sc[r] = expf(fminf(Rprev - fg[16 * w + 4 * g + r], 0.f));
        bf16* const hbase = C.HG + (size_t)(tokbase + 16 * w) * DM + h * 512;
        const bf16* const obase = C.PROJ + (size_t)(tokbase + 16 * w) * NPROJ + 8192 + h * 512;
        {
            __syncthreads();
            if (c > 0) { const int r = tid >> 5, ch = tid & 31; *(LAS v4u*)(X + r * 528 + ch * 16) = *(const v4u*)(C.ST + ((size_t)u * 528 + 512 + r) * 256 + ch * 8); }
            { LAS bf16* yt = (LAS bf16*)Y; for (int q = tid; q < 16 * 128; q += 512) yt[(q >> 7) * 136 + (q & 127)] = (bf16)(((q >> 7) == 0) ? 0x3F80u : 0u); }
            __syncthreads();
            f32x4 a = {0.f, 0.f, 0.f, 0.f};
            if (c > 0) {
#pragma unroll
                for (int s = 0; s < 8; ++s) a = mfma16(qf[s], *(const LAS bf16x8*)(X + (l & 15) * 528 + s * 64 + g * 16), a);
                a[0] *= sc[0]; a[1] *= sc[1]; a[2] *= sc[2]; a[3] *= sc[3];
            }
#pragma unroll
            for (int ks = 0; ks < 4; ++ks) a = mfma16(pf[ks], *(const LAS bf16x8*)(Y + (l & 15) * 272 + ks * 64 + g * 16), a);
#pragma unroll
            for (int r = 0; r < 4; ++r) { const int jrow = 16 * w + 4 * g + r; const float den = __shfl(a[r], l & 48);
                const float dn = fmaxf(fabsf(den), expf(-(ff[jrow] + fg[jrow]))); inv[r] = 1.0f / dn; }
        }
#pragma unroll 1
        for (int ec = 0; ec < 4; ++ec) {
            __syncthreads();
            v4u stg[8], vx[4];
            { const int i = tid & 127, cg = tid >> 7; const bf16* vrow = C.PROJ + (size_t)(tokbase + i) * NPROJ + 4096 + h * 512 + 128 * ec;
#pragma unroll
              for (int k = 0; k < 4; ++k) vx[k] = *(const v4u*)(vrow + (cg + 4 * k) * 8); }
            if (c > 0) {
#pragma unroll
                for (int it = 0; it < 8; ++it) { const int q = tid + 512 * it, r = q >> 5, ch = q & 31; stg[it] = *(const v4u*)(C.ST + ((size_t)u * 528 + 128 * ec + r) * 256 + ch * 8); }
#pragma unroll
                for (int it = 0; it < 8; ++it) { const int q = tid + 512 * it, r = q >> 5, ch = q & 31; *(LAS v4u*)(X + r * 528 + ch * 16) = stg[it]; }
            }
            { const int i = tid & 127, cg = tid >> 7; LAS bf16* yt = (LAS bf16*)Y;
#pragma unroll
              for (int k = 0; k < 4; ++k) { const int ch = cg + 4 * k; const v4u x = vx[k]; LAS bf16* dst = yt + (ch * 8) * 136 + i;
                  dst[0 * 136] = (bf16)(x.x & 0xffffu); dst[1 * 136] = (bf16)(x.x >> 16); dst[2 * 136] = (bf16)(x.y & 0xffffu); dst[3 * 136] = (bf16)(x.y >> 16);
                  dst[4 * 136] = (bf16)(x.z & 0xffffu); dst[5 * 136] = (bf16)(x.z >> 16); dst[6 * 136] = (bf16)(x.w & 0xffffu); dst[7 * 136] = (bf16)(x.w >> 16); } }
            __syncthreads();
            f32x4 acc[8];
#pragma unroll
            for (int t = 0; t < 8; ++t) acc[t] = (f32x4){0.f, 0.f, 0.f, 0.f};
            if (c > 0) {
#pragma unroll
                for (int et = 0; et < 8; ++et) {
#pragma unroll
                    for (int s = 0; s < 8; ++s) acc[et] = mfma16(qf[s], *(const LAS bf16x8*)(X + (16 * et + (l & 15)) * 528 + s * 64 + g * 16), acc[et]);
                    acc[et][0] *= sc[0]; acc[et][1] *= sc[1]; acc[et][2] *= sc[2]; acc[et][3] *= sc[3];
                    __builtin_amdgcn_sched_barrier(0);
                }
            }
#pragma unroll
            for (int et = 0; et < 8; ++et) {
#pragma unroll
                for (int ks = 0; ks < 4; ++ks) acc[et] = mfma16(pf[ks], *(const LAS bf16x8*)(Y + (16 * et + (l & 15)) * 272 + ks * 64 + g * 16), acc[et]);
#pragma unroll
                for (int r = 0; r < 4; ++r) { const float hv = acc[et][r] * inv[r]; ss[r] += hv * hv; Pw[(4 * g + r) * 136 + 16 * et + (l & 15)] = (bf16)(pg8::cvt_pk_bf16(hv, hv) & 0xffffu); }
                __builtin_amdgcn_sched_barrier(0);
            }
            LDS_WAIT();
#pragma unroll
            for (int i = 0; i < 4; ++i) { const int v = l + 64 * i, row = v >> 4, cv = v & 15;
                *(v4u*)(hbase + (size_t)row * DM + 128 * ec + cv * 8) = *(const LAS v4u*)((LAS unsigned char*)Pw + row * 272 + cv * 16); }
            LDS_WAIT();
        }
        {
#pragma unroll
            for (int r = 0; r < 4; ++r) { float t = ss[r]; t += __shfl_xor(t, 1); t += __shfl_xor(t, 2); t += __shfl_xor(t, 4); t += __shfl_xor(t, 8);
                const float rsv = 1.0f / sqrtf(t * (1.0f / 512.0f) + EPS); if ((l & 15) == 0) fa_rs[16 * w + 4 * g + r] = rsv; }
            LDS_WAIT(); VM_WAIT();
            const f32x4* hgp = (const f32x4*)(C.a_head_norm + h * 512) + 2 * l;
            const f32x4 hg0 = hgp[0], hg1 = hgp[1];
#pragma unroll 1
            for (int i4 = 0; i4 < 16; i4 += 4) {
                v4u hv4[4], ov4[4];
#pragma unroll
                for (int k = 0; k < 4; ++k) { hv4[k] = *(const v4u*)(hbase + (size_t)(i4 + k) * DM + 8 * l); ov4[k] = *(const v4u*)(obase + (size_t)(i4 + k) * NPROJ + 8 * l); }
#pragma unroll
                for (int k = 0; k < 4; ++k) {
                    const float rsv = fa_rs[16 * w + i4 + k]; const v4u hv = hv4[k], ov = ov4[k];
                    float o[8];
                    o[0] = bflo(hv.x) * hg0.x * __builtin_amdgcn_rcpf(1.0f + __builtin_amdgcn_exp2f(-1.4426950408889634f * bflo(ov.x)));
                    o[1] = bfhi(hv.x) * hg0.y * __builtin_amdgcn_rcpf(1.0f + __builtin_amdgcn_exp2f(-1.4426950408889634f * bfhi(ov.x)));
                    o[2] = bflo(hv.y) * hg0.z * __builtin_amdgcn_rcpf(1.0f + __builtin_amdgcn_exp2f(-1.4426950408889634f * bflo(ov.y)));
                    o[3] = bfhi(hv.y) * hg0.w * __builtin_amdgcn_rcpf(1.0f + __builtin_amdgcn_exp2f(-1.4426950408889634f * bfhi(ov.y)));
                    o[4] = bflo(hv.z) * hg1.x * __builtin_amdgcn_rcpf(1.0f + __builtin_amdgcn_exp2f(-1.4426950408889634f * bflo(ov.z)));
                    o[5] = bfhi(hv.z) * hg1.y * __builtin_amdgcn_rcpf(1.0f + __builtin_amdgcn_exp2f(-1.4426950408889634f * bfhi(ov.z)));
                    o[6] = bflo(hv.w) * hg1.z * __builtin_amdgcn_rcpf(1.0f + __builtin_amdgcn_exp2f(-1.4426950408889634f * bflo(ov.w)));
                    o[7] = bfhi(hv.w) * hg1.w * __builtin_amdgcn_rcpf(1.0f + __builtin_amdgcn_exp2f(-1.4426950408889634f * bfhi(ov.w)));
                    v4u wv; wv.x = pg8::cvt_pk_bf16(o[0] * rsv, o[1] * rsv); wv.y = pg8::cvt_pk_bf16(o[2] * rsv, o[3] * rsv); wv.z = pg8::cvt_pk_bf16(o[4] * rsv, o[5] * rsv); wv.w = pg8::cvt_pk_bf16(o[6] * rsv, o[7] * rsv);
                    *(v4u*)(hbase + (size_t)(i4 + k) * DM + 8 * l) = wv;
                }
            }
        }
    }
}

__device__ __forceinline__ void phase_conv(const Ctx& C0, int layer) {
    Ctx C = C0; C.lane = fresh_lane(); C.tid = C.wave * 64 + C.lane;
    const float* cw = C.ffn_conv_w + (size_t)layer * 3 * F2; const float* cb = C.ffn_conv_b + (size_t)layer * F2;
    constexpr int NCH = FF / 8;
    for (int idx = C.bid * NTHR + C.tid; idx < (MTOK / 16) * NCH; idx += C.G * NTHR) {
        const int ch = idx % NCH, tb = idx / NCH, t0 = tb * 16, c0 = ch * 8;
        float wg[3][8], wu[3][8], bg[8], bu[8], g2[8], g1[8], u2[8], u1[8];
#pragma unroll
        for (int j = 0; j < 3; ++j)
#pragma unroll
            for (int q = 0; q < 8; ++q) { wg[j][q] = cw[(size_t)j * F2 + c0 + q]; wu[j][q] = cw[(size_t)j * F2 + FF + c0 + q]; }
#pragma unroll
        for (int q = 0; q < 8; ++q) { bg[q] = cb[c0 + q]; bu[q] = cb[FF + c0 + q]; g2[q] = g1[q] = u2[q] = u1[q] = 0.f; }
        if ((t0 & (SEQ - 1)) != 0) {
            const v4u a = *(const v4u*)(C.HC + (size_t)(t0 - 2) * F2 + c0), bq = *(const v4u*)(C.HC + (size_t)(t0 - 1) * F2 + c0);
            const v4u cq = *(const v4u*)(C.HC + (size_t)(t0 - 2) * F2 + FF + c0), dq = *(const v4u*)(C.HC + (size_t)(t0 - 1) * F2 + FF + c0);
            g2[0] = bflo(a.x); g2[1] = bfhi(a.x); g2[2] = bflo(a.y); g2[3] = bfhi(a.y); g2[4] = bflo(a.z); g2[5] = bfhi(a.z); g2[6] = bflo(a.w); g2[7] = bfhi(a.w);
            g1[0] = bflo(bq.x); g1[1] = bfhi(bq.x); g1[2] = bflo(bq.y); g1[3] = bfhi(bq.y); g1[4] = bflo(bq.z); g1[5] = bfhi(bq.z); g1[6] = bflo(bq.w); g1[7] = bfhi(bq.w);
            u2[0] = bflo(cq.x); u2[1] = bfhi(cq.x); u2[2] = bflo(cq.y); u2[3] = bfhi(cq.y); u2[4] = bflo(cq.z); u2[5] = bfhi(cq.z); u2[6] = bflo(cq.w); u2[7] = bfhi(cq.w);
            u1[0] = bflo(dq.x); u1[1] = bfhi(dq.x); u1[2] = bflo(dq.y); u1[3] = bfhi(dq.y); u1[4] = bflo(dq.z); u1[5] = bfhi(dq.z); u1[6] = bflo(dq.w); u1[7] = bfhi(dq.w);
        }
#pragma unroll 4
        for (int q = 0; q < 16; ++q) {
            const v4u a = *(const v4u*)(C.HC + (size_t)(t0 + q) * F2 + c0), bq = *(const v4u*)(C.HC + (size_t)(t0 + q) * F2 + FF + c0);
            float gc[8], uc[8], o[8];
            gc[0] = bflo(a.x); gc[1] = bfhi(a.x); gc[2] = bflo(a.y); gc[3] = bfhi(a.y); gc[4] = bflo(a.z); gc[5] = bfhi(a.z); gc[6] = bflo(a.w); gc[7] = bfhi(a.w);
            uc[0] = bflo(bq.x); uc[1] = bfhi(bq.x); uc[2] = bflo(bq.y); uc[3] = bfhi(bq.y); uc[4] = bflo(bq.z); uc[5] = bfhi(bq.z); uc[6] = bflo(bq.w); uc[7] = bfhi(bq.w);
#pragma unroll
            for (int k = 0; k < 8; ++k) { const float gv = bg[k] + wg[0][k] * g2[k] + wg[1][k] * g1[k] + wg[2][k] * gc[k]; const float uv = bu[k] + wu[0][k] * u2[k] + wu[1][k] * u1[k] + wu[2][k] * uc[k];
                o[k] = gv / (1.0f + expf(-gv)) * uv; g2[k] = g1[k]; g1[k] = gc[k]; u2[k] = u1[k]; u1[k] = uc[k]; }
            v4u w; w.x = pk2(o[0], o[1]); w.y = pk2(o[2], o[3]); w.z = pk2(o[4], o[5]); w.w = pk2(o[6], o[7]);
            *(v4u*)(C.ACT + (size_t)(t0 + q) * FF + c0) = w;
        }
    }
}

__device__ __forceinline__ void phase_kmean(const Ctx& C0) {
    Ctx C = C0; C.lane = fresh_lane(); C.tid = C.wave * 64 + C.lane;
    LAS float* red = (LAS float*)C.lds;
    const int tid = C.tid, dch = tid & 15, kg = tid >> 4;
    for (int u = C.bid; u < 2048; u += C.G) {
        const int bh = u >> 5, n = u & 31, b = bh >> 5, h = bh & 31;
        float s[8];
#pragma unroll
        for (int j = 0; j < 8; ++j) s[j] = 0.f;
#pragma unroll
        for (int i = 0; i < 8; ++i) { const int key = kg + 32 * i; const v4u x = *(const v4u*)(C.PROJ + (size_t)(b * SEQ + n * 256 + key) * NPROJ + 4096 + h * 128 + dch * 8);
            s[0] += bflo(x.x); s[1] += bfhi(x.x); s[2] += bflo(x.y); s[3] += bfhi(x.y); s[4] += bflo(x.z); s[5] += bfhi(x.z); s[6] += bflo(x.w); s[7] += bfhi(x.w); }
        __syncthreads();
#pragma unroll
        for (int j = 0; j < 8; ++j) red[kg * 128 + dch * 8 + j] = s[j];
        __syncthreads();
        if (tid < 128) { float t = 0.f; for (int k = 0; k < 32; ++k) t += red[k * 128 + tid]; C.KM[(size_t)u * 128 + tid] = t * (1.0f / 256.0f); }
    }
}
#define TOP3_INS(s_, n_) do { const float _s = (s_); const unsigned _n = (n_); \
    if (_s > v0 || (_s == v0 && _n < i0)) { v2 = v1; i2 = i1; v1 = v0; i1 = i0; v0 = _s; i0 = _n; } \
    else if (_s > v1 || (_s == v1 && _n < i1)) { v2 = v1; i2 = i1; v1 = _s; i1 = _n; } \
    else if (_s > v2 || (_s == v2 && _n < i2)) { v2 = _s; i2 = _n; } } while (0)
__device__ __forceinline__ void phase_gating(const Ctx& C0) {
    Ctx C = C0; C.lane = fresh_lane(); C.tid = C.wave * 64 + C.lane;
    LAS unsigned char* KH = C.lds;
    LAS unsigned char* KLo = C.lds + 8704;
    const int tid = C.tid, l = C.lane, jq = l & 15, g = l >> 4, w = C.wave;
    for (int u = C.bid; u < 2048; u += C.G) {
        const int bh = u >> 5, qb = u & 31, b = bh >> 5, h = bh & 31;
        __syncthreads();
        for (int i = tid; i < 2048; i += 512) { const f32x2 va = *(const f32x2*)(C.KM + (size_t)bh * 4096 + 2 * i), vb = *(const f32x2*)(C.KM + (size_t)(64 * 32 * 128) + (size_t)bh * 4096 + 2 * i);
            const f32x2 v = (va + vb) * (1.0f / 256.0f); const int n = i >> 6, d = (i & 63) * 2;
            const unsigned hx = f2bf(v.x), hy = f2bf(v.y); const float rx = v.x - __uint_as_float(hx << 16), ry = v.y - __uint_as_float(hy << 16);
            *(LAS unsigned*)(KH + n * 272 + d * 2) = hx | (hy << 16); *(LAS unsigned*)(KLo + n * 272 + d * 2) = pk2(rx, ry); }
        __syncthreads();
#pragma unroll 1
        for (int qt = 0; qt < 2; ++qt) {
            const int t = qb * 256 + w * 32 + qt * 16 + jq;
            const bf16* qrow = C.PROJ + hm_off(0, b, h, t) + g * 8;
            f32x4 a0 = {0.f, 0.f, 0.f, 0.f}, a1 = {0.f, 0.f, 0.f, 0.f};
#pragma unroll
            for (int s = 0; s < 4; ++s) { const bf16x8 qf = *(const bf16x8*)(qrow + 32 * s);
                a0 = mfma16(*(const LAS bf16x8*)(KH + jq * 272 + s * 64 + g * 16), qf, a0); a1 = mfma16(*(const LAS bf16x8*)(KH + (16 + jq) * 272 + s * 64 + g * 16), qf, a1);
                a0 = mfma16(*(const LAS bf16x8*)(KLo + jq * 272 + s * 64 + g * 16), qf, a0); a1 = mfma16(*(const LAS bf16x8*)(KLo + (16 + jq) * 272 + s * 64 + g * 16), qf, a1); }
            float v0 = -INFINITY, v1 = -INFINITY, v2 = -INFINITY; unsigned i0 = 0xFFu, i1 = 0xFFu, i2 = 0xFFu;
#pragma unroll
            for (int r = 0; r < 4; ++r) { const int n = 4 * g + r; if (n < qb) TOP3_INS(a0[r], (unsigned)n); }
#pragma unroll
            for (int r = 0; r < 4; ++r) { const int n = 16 + 4 * g + r; if (n < qb) TOP3_INS(a1[r], (unsigned)n); }
#pragma unroll
            for (int sh = 16; sh <= 32; sh <<= 1) {
                const float p0 = __shfl_xor(v0, sh), p1 = __shfl_xor(v1, sh), p2 = __shfl_xor(v2, sh);
                const unsigned j0 = (unsigned)__shfl_xor((int)i0, sh), j1 = (unsigned)__shfl_xor((int)i1, sh), j2 = (unsigned)__shfl_xor((int)i2, sh);
                if (j0 != 0xFFu) TOP3_INS(p0, j0);
                if (j1 != 0xFFu) TOP3_INS(p1, j1);
                if (j2 != 0xFFu) TOP3_INS(p2, j2);
            }
            if (g == 0) C.SEL[(size_t)bh * SEQ + t] = (int)(i0 | (i1 << 8) | (i2 << 16));
        }
    }
}
__device__ __forceinline__ void moba_tile(const Ctx& C, LAS unsigned char* KL, LAS unsigned char* VT, int b, int h, int ent, bf16x8 (&qf)[4], const bf16x8 (&qn)[4], int nkt, bool causal, int blk0) {
    const int l = C.lane, jq = l & 15, g = l >> 4, gs = g ^ (((jq + 4) >> 3) & 1);
    const int t = ent & 0xFFFF, slot = (ent >> 16) & 3; const bool valid = ent >= 0;
    f32x4 st[16];
    constexpr float SCALE = 0.08838834764831845f, C2 = 0.08838834764831845f * 1.4426950408889634f;
    const int tq = t - blk0, npair = (nkt + 1) >> 1, dq = tq - 4 * g;
    float m = -INFINITY;
#pragma unroll
    for (int kp = 0; kp < 8; ++kp) {
        if (kp < npair) {
            bf16x8 k0[4], k1[4];
#pragma unroll
            for (int s = 0; s < 4; ++s) { k0[s] = *(const LAS bf16x8*)(KL + (32 * kp + jq) * 272 + s * 64 + gs * 16); k1[s] = *(const LAS bf16x8*)(KL + (32 * kp + 16 + jq) * 272 + s * 64 + gs * 16); }
            f32x4 a0 = {0.f, 0.f, 0.f, 0.f}, a1 = {0.f, 0.f, 0.f, 0.f};
#pragma unroll
            for (int s = 0; s < 4; ++s) { a0 = mfma16(k0[s], qf[s], a0); a1 = mfma16(k1[s], qf[s], a1); }
            if (causal && kp == npair - 1) {
#pragma unroll
                for (int r = 0; r < 4; ++r) { if (32 * kp + r > dq) a0[r] = -INFINITY; if (32 * kp + 16 + r > dq) a1[r] = -INFINITY; }
            }
            m = fmaxf(m, fmaxf(fmaxf(a0[0], a0[1]), fmaxf(a0[2], a0[3]))); m = fmaxf(m, fmaxf(fmaxf(a1[0], a1[1]), fmaxf(a1[2], a1[3])));
            st[2 * kp] = a0; st[2 * kp + 1] = a1;
        } else { st[2 * kp] = (f32x4){0.f, 0.f, 0.f, 0.f}; st[2 * kp + 1] = (f32x4){0.f, 0.f, 0.f, 0.f}; }
        __builtin_amdgcn_sched_barrier(0);
    }
    m = fmaxf(m, __shfl_xor(m, 16)); m = fmaxf(m, __shfl_xor(m, 32));
    const float mc = m * C2;
    float lsum = 0.f;
    f32x4 oacc[8];
#pragma unroll
    for (int et = 0; et < 8; ++et) oacc[et] = (f32x4){0.f, 0.f, 0.f, 0.f};
#pragma unroll
    for (int ks = 0; ks < 8; ++ks) {
        if (ks < npair) {
            float p[8];
#pragma unroll
            for (int r = 0; r < 4; ++r) { p[r] = __builtin_amdgcn_exp2f(st[2 * ks][r] * C2 - mc); p[4 + r] = __builtin_amdgcn_exp2f(st[2 * ks + 1][r] * C2 - mc); }
            lsum += ((p[0] + p[1]) + (p[2] + p[3])) + ((p[4] + p[5]) + (p[6] + p[7]));
            v4u pbu; pbu.x = pg8::cvt_pk_bf16(p[0], p[1]); pbu.y = pg8::cvt_pk_bf16(p[2], p[3]); pbu.z = pg8::cvt_pk_bf16(p[4], p[5]); pbu.w = pg8::cvt_pk_bf16(p[6], p[7]);
            const bf16x8 pb = __builtin_bit_cast(bf16x8, pbu);
            bf16x8 va[8];
#pragma unroll
            for (int et = 0; et < 8; ++et) va[et] = *(const LAS bf16x8*)(VT + (16 * et + jq) * 528 + ks * 64 + gs * 16);
#pragma unroll
            for (int et = 0; et < 8; ++et) oacc[et] = mfma16(va[et], pb, oacc[et]);
        }
        __builtin_amdgcn_sched_barrier(0);
    }
    lsum += __shfl_xor(lsum, 16); lsum += __shfl_xor(lsum, 32);
#pragma unroll
    for (int s4 = 0; s4 < 4; ++s4) qf[s4] = qn[s4];
    __builtin_amdgcn_sched_barrier(0);
    if (causal) {
        const int nv = (blk0 >> 8) < 3 ? (blk0 >> 8) : 3; const size_t tok = (size_t)b * SEQ + t;
        f32x2 mlv[3]; v2u xs[3][8];
#pragma unroll
        for (int s = 0; s < 3; ++s) { mlv[s] = *(const f32x2*)(C.ML + hm_off(s, b, h, t) / 64); const bf16* pp = C.PART + hm_off(s, b, h, t) + 4 * g;
#pragma unroll
            for (int et = 0; et < 8; ++et) xs[s][et] = *(const v2u*)(pp + 16 * et); }
        const float mo = m * SCALE; float M = mo; float ms[3], ls[3];
#pragma unroll
        for (int s = 0; s < 3; ++s) { ms[s] = (s < nv) ? mlv[s].x : -INFINITY; ls[s] = (s < nv) ? mlv[s].y : 0.f; M = fmaxf(M, ms[s]); }
        const float wo = __builtin_amdgcn_exp2f((mo - M) * 1.4426950408889634f); float W = lsum * wo;
#pragma unroll
        for (int et = 0; et < 8; ++et) oacc[et] = oacc[et] * wo;
#pragma unroll
        for (int s = 0; s < 3; ++s) {
            const float ws = (s < nv) ? __builtin_amdgcn_exp2f((ms[s] - M) * 1.4426950408889634f) * ls[s] : 0.f; W += ws;
#pragma unroll
            for (int et = 0; et < 8; ++et) { const unsigned xa = (s < nv) ? xs[s][et].x : 0u, xb = (s < nv) ? xs[s][et].y : 0u;
                oacc[et][0] += ws * bflo(xa); oacc[et][1] += ws * bfhi(xa); oacc[et][2] += ws * bflo(xb); oacc[et][3] += ws * bfhi(xb); }
        }
        const float inv = __builtin_amdgcn_rcpf(W);
#pragma unroll
        for (int et = 0; et < 8; ++et) { v2u o; o.x = pg8::cvt_pk_bf16(oacc[et][0] * inv, oacc[et][1] * inv); o.y = pg8::cvt_pk_bf16(oacc[et][2] * inv, oacc[et][3] * inv);
            *(v2u*)(C.HG + tok * DM + h * 128 + 16 * et + 4 * g) = o; }
    } else if (valid) {
        const float inv = __builtin_amdgcn_rcpf(lsum); const size_t prow = hm_off(slot, b, h, t);
#pragma unroll
        for (int et = 0; et < 8; ++et) { v2u o; o.x = pg8::cvt_pk_bf16(oacc[et][0] * inv, oacc[et][1] * inv); o.y = pg8::cvt_pk_bf16(oacc[et][2] * inv, oacc[et][3] * inv);
            *(v2u*)(C.PART + prow + 16 * et + 4 * g) = o; }
        if (g == 0) *(f32x2*)(C.ML + prow / 64) = (f32x2){m * SCALE, lsum};
    }
}
__device__ __forceinline__ void phase_moba_attn(const Ctx& C0, int rep, const XcdBarrier& bar) {
    Ctx C = C0; C.lane = fresh_lane(); C.tid = C.wave * 64 + C.lane;
    LAS unsigned char* KL = C.lds;
    LAS unsigned char* VT = C.lds + 69632;
    LAS int* LIST = (LAS int*)(C.lds + 137216);
    LAS int* cnt = (LAS int*)(C.lds + 153600);
    volatile LAS int* wq = (volatile LAS int*)(C.lds + 153604);
    const int tid = C.tid, l = C.lane, w = C.wave, jq = l & 15, g = l >> 4;
    constexpr int NSEL = 31 * 64, NOWN = 32 * 64;
#ifndef MOBA_REPS
#define MOBA_REPS 1
#endif
    int pass = 0, own_i = C.bid, rr = 0;
    for (;;) {
        int item;
        if (pass == 0) {
            __syncthreads();
            if (tid == 0) *wq = (int)__hip_atomic_fetch_add(C.ctl + CW_WQ + 64 * (rep + 2 * rr), 1u, RLX_AGENT);
            __syncthreads();
            item = *wq;
            if (item >= NSEL) { xcd_barrier(bar); pass = 1; continue; }
        } else {
            if (own_i >= NOWN) { if (++rr < MOBA_REPS) { xcd_barrier(bar); pass = 0; own_i = C.bid; continue; } break; }
            item = NSEL + own_i; own_i += C.G;
            __syncthreads();
        }
        const bool selu = item < NSEL;
        const int n = selu ? (item >> 6) : ((item - NSEL) >> 6), bh = item & 63, b = bh >> 5, h = bh & 31;
        bf16x8 q0[4];
#pragma unroll
        for (int s4 = 0; s4 < 4; ++s4) q0[s4] = (bf16x8){0, 0, 0, 0, 0, 0, 0, 0};
        if (!selu) { const bf16* qrow = C.PROJ + hm_off(0, b, h, n * 256 + 16 * w + jq) + g * 8;
#pragma unroll
            for (int s4 = 0; s4 < 4; ++s4) q0[s4] = *(const bf16x8*)(qrow + 32 * s4); }
        { const bf16* krow0 = C.PROJ + hm_off(1, b, h, n * 256);
          int tid = C.tid; asm volatile("" : "+v"(tid));
          v4u kk[8];
#pragma unroll
          for (int it = 0; it < 8; ++it) { const int q = tid + 512 * it, key = q >> 4, ch = q & 15; kk[it] = *(const v4u*)(krow0 + key * 128 + ch * 8); }
          const int key = tid & 255, cg = tid >> 8; const bf16* vrow = C.PROJ + hm_off(2, b, h, n * 256 + key); LAS bf16* vt = (LAS bf16*)VT;
          v4u vv[8];
#pragma unroll
          for (int k = 0; k < 8; ++k) vv[k] = *(const v4u*)(vrow + (cg + 2 * k) * 8);
#pragma unroll
          for (int it = 0; it < 8; ++it) { const int q = tid + 512 * it, key2 = q >> 4, ch = (q & 15) ^ (((key2 + 4) >> 3) & 1); *(LAS v4u*)(KL + key2 * 272 + ch * 16) = kk[it]; }
          const int keyp = (key & ~31) + 8 * ((key & 15) >> 2) + 4 * ((key >> 4) & 1) + (key & 3);
#pragma unroll
          for (int k = 0; k < 8; ++k) { const int ch = cg + 2 * k; const v4u x = vv[k]; const int e8 = (ch & 1) * 8;
              LAS bf16* dstA = vt + (ch * 8) * 264 + keyp;
              LAS bf16* dstB = vt + (ch * 8) * 264 + (keyp ^ 8);
              LAS bf16* d0 = e8 ? dstB : dstA; LAS bf16* d1 = e8 ? dstA : dstB;
              d0[0 * 264] = (bf16)(x.x & 0xffffu); d0[1 * 264] = (bf16)(x.x >> 16); d0[2 * 264] = (bf16)(x.y & 0xffffu); d0[3 * 264] = (bf16)(x.y >> 16);
              d1[4 * 264] = (bf16)(x.z & 0xffffu); d1[5 * 264] = (bf16)(x.z >> 16); d1[6 * 264] = (bf16)(x.w & 0xffffu); d1[7 * 264] = (bf16)(x.w >> 16); } }
        const int tstart = (n + 1) * 256, nbatch = selu ? ((SEQ - tstart + 4095) >> 12) : 1;
        for (int bi = 0; bi < nbatch; ++bi) {
            int count = 256;
            if (selu) {
                __syncthreads();
                if (tid == 0) *cnt = 0;
                __syncthreads();
                const int b0 = tstart + bi * 4096, b1 = (b0 + 4096 < SEQ) ? b0 + 4096 : SEQ;
                int sel[8];
#pragma unroll
                for (int it = 0; it < 8; ++it) { const int t = b0 + it * 512 + tid; sel[it] = (t < b1) ? C.SEL[(size_t)bh * SEQ + t] : 0x00FFFFFF; }
#pragma unroll
                for (int it = 0; it < 8; ++it) { const int t = b0 + it * 512 + tid;
                    int slot = -1;
                    if ((sel[it] & 255) == n) slot = 0; else if (((sel[it] >> 8) & 255) == n) slot = 1; else if (((sel[it] >> 16) & 255) == n) slot = 2;
                    const bool match = slot >= 0;
                    const unsigned long long mask = __ballot(match);
                    if (mask) { int base = 0; if (l == 0) base = __hip_atomic_fetch_add(cnt, (int)__popcll(mask), __ATOMIC_RELAXED, __HIP_MEMORY_SCOPE_WORKGROUP);
                        base = __builtin_amdgcn_readfirstlane(base);
                        if (match) LIST[base + __popcll(mask & ((1ull << l) - 1ull))] = t | (slot << 16); } }
                __syncthreads();
                count = *cnt;
            } else __syncthreads();
            const int ntile = (count + 15) >> 4;
            int ti = selu ? w - 8 : w;
            int ent = selu ? (int)0x80000000 : ((n * 256 + 16 * w + jq) | (3 << 16));
            bf16x8 qf[4], qn[4];
#pragma unroll
            for (int s4 = 0; s4 < 4; ++s4) { qf[s4] = q0[s4]; qn[s4] = (bf16x8){0, 0, 0, 0, 0, 0, 0, 0}; }
            for (;;) {
                const int tn = ti + 8; int entn = (int)0x80000000;
                const int tno = (tn < 8) ? tn : 23 - tn;
                if (tn < ntile) { entn = selu ? ((16 * tn + jq < count) ? LIST[16 * tn + jq] : (int)0x80000000) : ((n * 256 + 16 * tno + jq) | (3 << 16));
                    const bf16* qrow = C.PROJ + hm_off(0, b, h, entn & 0xFFFF) + g * 8;
#pragma unroll
                    for (int s4 = 0; s4 < 4; ++s4) qn[s4] = *(const bf16x8*)(qrow + 32 * s4); }
                if (ti >= 0) moba_tile(C, KL, VT, b, h, ent, qf, qn, selu ? 16 : ((ti < 8) ? ti : 23 - ti) + 1, !selu, n * 256);
                else {
#pragma unroll
                    for (int s4 = 0; s4 < 4; ++s4) qf[s4] = qn[s4]; }
                if (tn >= ntile) break;
                ent = entn; ti = tn;
            }
        }
    }
}
__device__ __forceinline__ void phase_moba_combine(const Ctx& C0) {
    Ctx C = C0; C.lane = fresh_lane(); C.tid = C.wave * 64 + C.lane;
    for (int idx = C.bid * NTHR + C.tid; idx < MTOK * 32 * 16; idx += C.G * NTHR) {
        const int ch = idx & 15, h = (idx >> 4) & 31, tok = idx >> 9, qb = (tok & (SEQ - 1)) >> 8, nv = qb < 3 ? qb : 3;
        float mm[4], ll[4], wgt[4];
        { const f32x2 v = *(const f32x2*)(C.ML + (((size_t)3 * MTOK + tok) * 32 + h) * 2); mm[3] = v.x; ll[3] = v.y; }
        float M = mm[3];
#pragma unroll
        for (int s = 0; s < 3; ++s) { if (s < nv) { const f32x2 v = *(const f32x2*)(C.ML + (((size_t)s * MTOK + tok) * 32 + h) * 2); mm[s] = v.x; ll[s] = v.y; M = fmaxf(M, v.x); } else { mm[s] = -INFINITY; ll[s] = 0.f; } }
        float W = 0.f;
#pragma unroll
        for (int s = 0; s < 4; ++s) { wgt[s] = (s == 3 || s < nv) ? expf(mm[s] - M) * ll[s] : 0.f; W += wgt[s]; }
        const float iw = 1.0f / W;
        float o[8];
#pragma unroll
        for (int j = 0; j < 8; ++j) o[j] = 0.f;
#pragma unroll
        for (int s = 0; s < 4; ++s) {
            if (s == 3 || s < nv) { const v4u x = *(const v4u*)(C.PART + ((size_t)s * MTOK + tok) * DM + h * 128 + ch * 8); const float ws = wgt[s] * iw;
                o[0] += ws * bflo(x.x); o[1] += ws * bfhi(x.x); o[2] += ws * bflo(x.y); o[3] += ws * bfhi(x.y); o[4] += ws * bflo(x.z); o[5] += ws * bfhi(x.z); o[6] += ws * bflo(x.w); o[7] += ws * bfhi(x.w); }
        }
        v4u wv; wv.x = pk2(o[0], o[1]); wv.y = pk2(o[2], o[3]); wv.z = pk2(o[4], o[5]); wv.w = pk2(o[6], o[7]);
        *(v4u*)(C.HG + (size_t)tok * DM + h * 128 + ch * 8) = wv;
    }
}

struct Args { const float* in[14]; float* out; unsigned char* ws; int ph_lo, ph_hi; };
__global__ void __launch_bounds__(NTHR, 2) hybrid_fwd(Args args) {
    extern __shared__ __attribute__((aligned(16))) unsigned char lds_raw[];
    Ctx C;
    C.lds = (LAS unsigned char*)lds_raw;
    C.tid = threadIdx.x; C.lane = C.tid & 63; C.wave = __builtin_amdgcn_readfirstlane(C.tid >> 6); C.G = gridDim.x; C.bid = blockIdx.x;
    C.x = args.in[0]; C.norm_mix = args.in[1]; C.norm_ffn = args.in[2]; C.a_w_in = args.in[3]; C.a_gate_bias = args.in[4]; C.a_head_norm = args.in[5]; C.a_w_out = args.in[6];
    C.b_w_qkv = args.in[7]; C.b_w_out = args.in[8]; C.ffn_w_up = args.in[9]; C.ffn_conv_w = args.in[10]; C.ffn_conv_b = args.in[11]; C.ffn_w_down = args.in[12]; C.final_norm = args.in[13];
    C.out = args.out;
    unsigned char* ws = args.ws;
    C.ctl = (unsigned*)(ws + WS_CTL);
    C.Win = (bf16*)(ws + WS_WIN); C.Wg = (bf16*)(ws + WS_WG); C.Wao = (bf16*)(ws + WS_WAO); C.Wqkv = (bf16*)(ws + WS_WQKV); C.Wbo = (bf16*)(ws + WS_WBO);
    C.Wup0 = (bf16*)(ws + WS_WUP0); C.Wup1 = (bf16*)(ws + WS_WUP1); C.Wdn0 = (bf16*)(ws + WS_WDN0); C.Wdn1 = (bf16*)(ws + WS_WDN1);
    C.X = (float*)(ws + WS_X); C.XN = (bf16*)(ws + WS_XN); C.HG = (bf16*)(ws + WS_HG);
    C.GATES = (float*)(ws + WS_GATES); C.FA = (float*)(ws + WS_FA); C.FG = (float*)(ws + WS_FG); C.FFv = (float*)(ws + WS_FF); C.KM = (float*)(ws + WS_KM); C.ML = (float*)(ws + WS_ML); C.SEL = (int*)(ws + WS_SEL);
    C.PROJ = (bf16*)(ws + WS_PROJ); C.UT = (bf16*)(ws + WS_UT); C.ST = (bf16*)(ws + WS_ST); C.HC = (bf16*)(ws + WS_HC); C.ACT = (bf16*)(ws + WS_ACT); C.PART = (bf16*)(ws + WS_PART);
    C.HALO = (float*)(ws + WS_HC); C.HEAD = (float*)(ws + WS_HC + 16 * MiB); C.SS = (float*)(ws + WS_SS); C.Xb = (bf16*)(ws + WS_X);
    C.A8 = (signed char*)(ws + WS_XN); C.Wao8 = (signed char*)(ws + WS_WAO); C.Wqkv8 = (signed char*)(ws + WS_WQKV); C.Wbo8 = (signed char*)(ws + WS_WBO); C.Wup08 = (signed char*)(ws + WS_WUP0); C.Wup18 = (signed char*)(ws + WS_WUP1); C.Wdn08 = (signed char*)(ws + WS_WDN0); C.Wdn18 = (signed char*)(ws + WS_WDN1); C.ACT8 = (signed char*)(ws + WS_BIG + 64 * MiB); C.Win8 = (signed char*)(ws + WS_WIN + 64 * MiB); C.XN8 = (signed char*)(ws + WS_HG); C.SA = (float*)(ws + WS_SA);

    volatile LAS unsigned* MISC = (volatile LAS unsigned*)(C.lds + MISC_OFF);
    if (C.tid < 64) MISC[C.tid] = 0u;
    __syncthreads();
    const int lo = args.ph_lo, hi = args.ph_hi;
    XcdBarrier bar; bar.bar = C.ctl + CW_BAR; bar.x = 0; bar.st = nullptr;
    if (hi - lo > 1) bar = xcd_barrier_post(C.ctl + CW_BAR, MISC + 8);
#ifdef ONLY_PHASE
#define IN(k) ((k) == ONLY_PHASE && lo <= (k) && (k) < hi)
#else
#define IN(k) (lo <= (k) && (k) < hi)
#endif
#define SEAM(k) do { if (IN(k) && IN((k) + 1)) xcd_barrier(bar); } while (0)
#ifndef REP_MASK
#define REP_MASK 0u
#endif
#define REPS(k) ((((REP_MASK) >> (k)) & 1u) ? 2 : 1)
#define REPSEAM(k, rep) do { if ((rep) + 1 < REPS(k)) xcd_barrier(bar); } while (0)

    if (IN(0)) { { const int rep = 0; (void)rep; phase_prologue(C); } if (REPS(0) == 2) { xcd_barrier(bar); { const int rep = 1; (void)rep; phase_prologue(C); } } } SEAM(0);
    phase_quant_weights(C); __syncthreads();
    if (IN(1)) { { const int rep = 0; (void)rep; { EpiStoreBf16 E{C.PROJ, NPROJ, nullptr, nullptr}; run_gemm(C, C.XN, C.Win, 8192, DM, E); } __syncthreads(); { EpiStoreBf16I8 E8{C.PROJ + 8192, NPROJ, nullptr, nullptr, C.SA, C.ctl + CW_WMAX_INO}; run_gemm_i8(C, C.XN8, C.Win8, 4096, DM, E8); } phase_gates(C); } if (REPS(1) == 2) { xcd_barrier(bar); { const int rep = 1; (void)rep; { EpiStoreBf16 E{C.PROJ, NPROJ, nullptr, nullptr}; run_gemm(C, C.XN, C.Win, 8192, DM, E); } __syncthreads(); { EpiStoreBf16I8 E8{C.PROJ + 8192, NPROJ, nullptr, nullptr, C.SA, C.ctl + CW_WMAX_INO}; run_gemm_i8(C, C.XN8, C.Win8, 4096, DM, E8); } phase_gates(C); } } } SEAM(1);
    if (IN(2)) { { const int rep = 0; (void)rep; phase_gate_scan(C); } if (REPS(2) == 2) { xcd_barrier(bar); { const int rep = 1; (void)rep; phase_gate_scan(C); } } } SEAM(2);
    if (IN(3)) { { const int rep = 0; (void)rep; phase_mlstm_u(C); } if (REPS(3) == 2) { xcd_barrier(bar); { const int rep = 1; (void)rep; phase_mlstm_u(C); } } } SEAM(3);
    if (IN(4)) { { const int rep = 0; (void)rep; phase_mlstm_scan(C); } if (REPS(4) == 2) { xcd_barrier(bar); { const int rep = 1; (void)rep; phase_mlstm_scan(C); } } } SEAM(4);
    if (IN(5)) { { const int rep = 0; (void)rep; phase_mlstm_out(C); } if (REPS(5) == 2) { xcd_barrier(bar); { const int rep = 1; (void)rep; phase_mlstm_out(C); } } } SEAM(5);
    phase_quant_rows<false>(C, C.HG, C.A8, C.SA); xcd_barrier(bar);
    if (IN(6)) { { const int rep = 0; (void)rep; EpiResidBfI8 E{C.x, nullptr, C.Xb, C.SS, C.lds + 131072, C.SA, C.ctl + CW_WMAX_AO}; run_gemm_i8(C, C.A8, C.Wao8, DM, DM, E); } if (REPS(6) == 2) { xcd_barrier(bar); { const int rep = 1; (void)rep; EpiResidBfI8 E{C.x, nullptr, C.Xb, C.SS, C.lds + 131072, C.SA, C.ctl + CW_WMAX_AO}; run_gemm_i8(C, C.A8, C.Wao8, DM, DM, E); } } } SEAM(6);
    phase_quant_rows<true>(C, C.Xb, C.A8, C.SA); xcd_barrier(bar);
    if (IN(8)) { { const int rep = 0; (void)rep; EpiConvActI8 E{C.ACT, C.ffn_conv_w, C.ffn_conv_b, C.HALO, C.HEAD, C.lds + 131072, C.SS, C.SA, C.ctl + CW_WMAX_UP0}; run_gemm_i8(C, C.A8, C.Wup08, F2, DM, E); } if (REPS(8) == 2) { xcd_barrier(bar); { const int rep = 1; (void)rep; EpiConvActI8 E{C.ACT, C.ffn_conv_w, C.ffn_conv_b, C.HALO, C.HEAD, C.lds + 131072, C.SS, C.SA, C.ctl + CW_WMAX_UP0}; run_gemm_i8(C, C.A8, C.Wup08, F2, DM, E); } } } SEAM(8);
    if (IN(9)) { { const int rep = 0; (void)rep; phase_conv_fixup(C, 0); } if (REPS(9) == 2) { xcd_barrier(bar); { const int rep = 1; (void)rep; phase_conv_fixup(C, 0); } } } SEAM(9);
    phase_quant_act(C); xcd_barrier(bar);
    if (IN(10)) { { const int rep = 0; (void)rep; EpiResidBfI8 E{nullptr, C.Xb, C.Xb, C.SS, C.lds + 131072, C.SA, C.ctl + CW_WMAX_DN0}; run_gemm_i8(C, C.ACT8, C.Wdn08, DM, FF, E); } if (REPS(10) == 2) { xcd_barrier(bar); { const int rep = 1; (void)rep; EpiResidBfI8 E{nullptr, C.Xb, C.Xb, C.SS, C.lds + 131072, C.SA, C.ctl + CW_WMAX_DN0}; run_gemm_i8(C, C.ACT8, C.Wdn08, DM, FF, E); } } } SEAM(10);
    phase_quant_rows<true>(C, C.Xb, C.A8, C.SA); xcd_barrier(bar);
    if (IN(12)) { { const int rep = 0; (void)rep; EpiStoreBf16I8 E{C.PROJ, NPROJ, nullptr, C.KM, C.SA, C.ctl + CW_WMAX_QKV, true}; run_gemm_i8(C, C.A8, C.Wqkv8, NPROJ, DM, E); } if (REPS(12) == 2) { xcd_barrier(bar); { const int rep = 1; (void)rep; EpiStoreBf16I8 E{C.PROJ, NPROJ, nullptr, C.KM, C.SA, C.ctl + CW_WMAX_QKV, true}; run_gemm_i8(C, C.A8, C.Wqkv8, NPROJ, DM, E); } } } SEAM(12);
    if (IN(14)) { { const int rep = 0; (void)rep; phase_gating(C); } if (REPS(14) == 2) { xcd_barrier(bar); { const int rep = 1; (void)rep; phase_gating(C); } } } SEAM(14);
    if (IN(15)) { { const int rep = 0; (void)rep; phase_moba_attn(C, rep, bar); } if (REPS(15) == 2) { xcd_barrier(bar); { const int rep = 1; (void)rep; phase_moba_attn(C, rep, bar); } } } SEAM(15);
    phase_quant_rows<false>(C, C.HG, C.A8, C.SA); xcd_barrier(bar);
    if (IN(17)) { { const int rep = 0; (void)rep; EpiResidBfI8 E{nullptr, C.Xb, C.Xb, C.SS, C.lds + 131072, C.SA, C.ctl + CW_WMAX_BO}; run_gemm_i8(C, C.A8, C.Wbo8, DM, DM, E); } if (REPS(17) == 2) { xcd_barrier(bar); { const int rep = 1; (void)rep; EpiResidBfI8 E{nullptr, C.Xb, C.Xb, C.SS, C.lds + 131072, C.SA, C.ctl + CW_WMAX_BO}; run_gemm_i8(C, C.A8, C.Wbo8, DM, DM, E); } } } SEAM(17);
    phase_quant_rows<true>(C, C.Xb, C.A8, C.SA); xcd_barrier(bar);
    if (IN(19)) { { const int rep = 0; (void)rep; EpiConvActI8 E{C.ACT, C.ffn_conv_w + (size_t)3 * F2, C.ffn_conv_b + F2, C.HALO, C.HEAD, C.lds + 131072, C.SS, C.SA, C.ctl + CW_WMAX_UP1}; run_gemm_i8(C, C.A8, C.Wup18, F2, DM, E); } if (REPS(19) == 2) { xcd_barrier(bar); { const int rep = 1; (void)rep; EpiConvActI8 E{C.ACT, C.ffn_conv_w + (size_t)3 * F2, C.ffn_conv_b + F2, C.HALO, C.HEAD, C.lds + 131072, C.SS, C.SA, C.ctl + CW_WMAX_UP1}; run_gemm_i8(C, C.A8, C.Wup18, F2, DM, E); } } } SEAM(19);
    if (IN(20)) { { const int rep = 0; (void)rep; phase_conv_fixup(C, 1); } if (REPS(20) == 2) { xcd_barrier(bar); { const int rep = 1; (void)rep; phase_conv_fixup(C, 1); } } } SEAM(20);
    phase_quant_act(C); xcd_barrier(bar);
    if (IN(21)) { { const int rep = 0; (void)rep; EpiResidBfI8 E{nullptr, C.Xb, C.Xb, C.SS, C.lds + 131072, C.SA, C.ctl + CW_WMAX_DN1}; run_gemm_i8(C, C.ACT8, C.Wdn18, DM, FF, E); } if (REPS(21) == 2) { xcd_barrier(bar); { const int rep = 1; (void)rep; EpiResidBfI8 E{nullptr, C.Xb, C.Xb, C.SS, C.lds + 131072, C.SA, C.ctl + CW_WMAX_DN1}; run_gemm_i8(C, C.ACT8, C.Wdn18, DM, FF, E); } } } SEAM(21);
    if (IN(22)) { const int gw = C.bid * NWAVES + C.wave, NGW = C.G * NWAVES, ln22 = fresh_lane();
        for (int m = gw; m < MTOK; m += NGW) rms_row_bf16_to_f32(C.Xb + (size_t)m * DM, C.final_norm, C.out + (size_t)m * DM, ln22); }
#undef IN
#undef SEAM
}

extern "C" void kernel_launch(void* const* d_in, const int* in_sizes, int n_in, void* d_out, int out_size, void* d_ws, size_t ws_size, hipStream_t stream) {
    static int grid = 0;
    if (grid == 0) {
        if (n_in != 14 || out_size != MTOK * DM || ws_size < WS_END) { fprintf(stderr, "kernel_launch: unexpected shapes (n_in %d, out %d, ws %zu < %zu)\n", n_in, out_size, ws_size, (size_t)WS_END); grid = -1; return; }
        int dev = 0, cus = 0, per_cu = 0;
        if (hipGetDevice(&dev) != hipSuccess || hipDeviceGetAttribute(&cus, hipDeviceAttributeMultiprocessorCount, dev) != hipSuccess) { grid = -1; return; }
        if (hipFuncSetAttribute((const void*)hybrid_fwd, hipFuncAttributeMaxDynamicSharedMemorySize, LDS_BYTES) != hipSuccess) { fprintf(stderr, "kernel_launch: hipFuncSetAttribute failed\n"); grid = -1; return; }
        if (hipOccupancyMaxActiveBlocksPerMultiprocessor(&per_cu, (const void*)hybrid_fwd, NTHR, LDS_BYTES) != hipSuccess || per_cu < 1) fprintf(stderr, "kernel_launch: occupancy query reports %d\n", per_cu);
        (void)hipGetLastError();
        grid = cus;
    }
    if (grid < 0) return;
    if (hipMemsetAsync((char*)d_ws + WS_CTL, 0, CTL_ZERO_BYTES, stream) != hipSuccess) return;
    Args a{};
    for (int i = 0; i < 14; ++i) a.in[i] = (const float*)d_in[i];
    a.out = (float*)d_out; a.ws = (unsigned char*)d_ws;
#if MK_PER_PHASE
    for (int p = 0; p < NPHASE; ++p) { a.ph_lo = p; a.ph_hi = p + 1; hipLaunchKernelGGL(hybrid_fwd, dim3(grid), dim3(NTHR), LDS_BYTES, stream, a); }
#else
    a.ph_lo = 0; a.ph_hi = NPHASE;
    hipLaunchKernelGGL(hybrid_fwd, dim3(grid), dim3(NTHR), LDS_BYTES, stream, a);
#endif
    const hipError_t le = hipPeekAtLastError();
    if (le != hipSuccess) fprintf(stderr, "kernel_launch: launch failed: %s\n", hipGetErrorName(le));
}
```
